# Optimizing an MI355X kernel written in HIP

```python
import math
import jax, jax.numpy as jnp
from jax import lax
import numpy as np

D_MODEL = 1024
BATCH = 8
SEQ = 4096
DEPTH = 2

CTX_LEN = 256
GRID_W = 64
D_MIX = D_MODEL
A_HEADS = 4
A_HEAD_DIM = 64
A_VDIM = 2 * A_HEAD_DIM
A_QK = A_HEADS * 2 * A_HEAD_DIM
A_WIDTH = A_HEADS * A_VDIM
B_WIDTH = 256
SHORT_CONV = 3
C_WIDTH = 256
CONF_CONV = 31
Q_BLOCK = 128
ROPE_BASE = 10000.0
EPS = 1e-6

Q_OFF = 0
K_OFF = Q_OFF + A_QK
V_OFF = K_OFF + A_QK
GA_OFF = V_OFF + A_WIDTH
BB_OFF = GA_OFF + A_WIDTH
BC_OFF = BB_OFF + B_WIDTH
BH_OFF = BC_OFF + B_WIDTH
GB_OFF = BH_OFF + B_WIDTH
CA_OFF = GB_OFF + B_WIDTH
CB_OFF = CA_OFF + C_WIDTH
GC_OFF = CB_OFF + C_WIDTH
D_IN = GC_OFF + C_WIDTH

kernel_name = "hybrid_diffattn_shortconv_conformer_dit"


def rmsnorm(x, g):
    xf = x.astype(jnp.float32)
    y = xf * lax.rsqrt(jnp.mean(xf * xf, axis=-1, keepdims=True) + EPS)
    return (y * g.astype(jnp.float32)).astype(x.dtype)


def layernorm(x, g, b):
    xf = x.astype(jnp.float32)
    mu = jnp.mean(xf, axis=-1, keepdims=True)
    xc = xf - mu
    var = jnp.mean(xc * xc, axis=-1, keepdims=True)
    return (xc * lax.rsqrt(var + EPS) * g.astype(jnp.float32) + b.astype(jnp.float32)).astype(x.dtype)


def modulation(cond, w_ada, b_ada):
    m = jax.nn.silu(cond) @ w_ada + b_ada
    return jnp.split(m, 3, axis=-1)


def axial_rope_tables(rows):
    r = jnp.repeat(jnp.arange(rows, dtype=jnp.float32), GRID_W)
    col = jnp.tile(jnp.arange(GRID_W, dtype=jnp.float32), rows)
    half = A_HEAD_DIM // 2
    inv_freq = ROPE_BASE ** (-jnp.arange(0, half, 2, dtype=jnp.float32) / half)
    ang = jnp.concatenate([r[:, None] * inv_freq, col[:, None] * inv_freq], axis=-1)
    return jnp.cos(ang), jnp.sin(ang)


def apply_axial_rope(t, cos, sin):
    tp = t.reshape(*t.shape[:-1], A_HEAD_DIM // 2, 2)
    t0, t1 = tp[..., 0], tp[..., 1]
    c = cos[None, :, None, None, :].astype(t.dtype)
    s = sin[None, :, None, None, :].astype(t.dtype)
    return jnp.stack([t0 * c - t1 * s, t0 * s + t1 * c], axis=-1).reshape(t.shape)


def dwconv(u, w):
    pad = w.shape[0] // 2
    return lax.conv_general_dilated(
        u, w[:, None, :].astype(u.dtype), window_strides=(1,), padding=[(pad, pad)],
        dimension_numbers=('NWC', 'WIO', 'NWC'), feature_group_count=u.shape[-1])


def diff_attend(q, k, v, lam):
    s = jnp.einsum('bqhmd,bkhmd->bhmqk', q, k, preferred_element_type=jnp.float32) * (A_HEAD_DIM ** -0.5)
    p = jax.nn.softmax(s, axis=-1)
    a = p[:, :, 0] - lam * p[:, :, 1]
    return jnp.einsum('bhqk,bkhe->bqhe', a.astype(v.dtype), v)


def latent_diff_attention(q, k_all, v_all, lam):
    b, s = q.shape[0], q.shape[1]
    nb = s // Q_BLOCK
    qb = q.reshape(b, nb, Q_BLOCK, *q.shape[2:]).swapaxes(0, 1)
    out = lax.map(lambda qi: diff_attend(qi, k_all, v_all, lam), qb)
    return out.swapaxes(0, 1).reshape(b, s, A_HEADS, A_VDIM)


def split_columns(p):
    return jnp.split(p, [K_OFF, V_OFF, GA_OFF, BB_OFF, BC_OFF, BH_OFF, GB_OFF, CA_OFF, CB_OFF, GC_OFF], axis=-1)


def heads_qk(t):
    return t.reshape(t.shape[0], t.shape[1], A_HEADS, 2, A_HEAD_DIM)


def heads_v(t):
    return t.reshape(t.shape[0], t.shape[1], A_HEADS, A_VDIM)


def attn_group_out(o, gate, g_sub, lam_init):
    o = rmsnorm(o, g_sub) * (1.0 - lam_init)
    return o.reshape(o.shape[0], o.shape[1], A_WIDTH) * jax.nn.silu(gate)


def conv_groups_out(bb, bc, bh, gb, ca, cb, gc, w_short, w_conf, b_conf, g_ln, b_ln):
    yb = bb * dwconv(bc * bh, w_short) * jax.nn.silu(gb)
    u = ca * jax.nn.sigmoid(cb)
    u = dwconv(u, w_conf) + b_conf
    yc = jax.nn.silu(layernorm(u, g_ln, b_ln)) * jax.nn.silu(gc)
    return yb, yc


def setup_inputs(seed: int = 0) -> dict:
    key = jax.random.key(seed)
    ks = jax.random.split(key, 24)
    f32 = jnp.float32
    n = lambda k, shape: jax.random.normal(k, shape, f32)
    return {
        'x': n(ks[0], (BATCH, SEQ, D_MODEL)),
        'c': n(ks[1], (BATCH, D_MODEL)),
        'ctx': n(ks[2], (BATCH, CTX_LEN, D_MODEL)),
        'c_ctx': 0.5 * n(ks[3], (D_MODEL,)),
        'w_ada': n(ks[4], (DEPTH, D_MODEL, 3 * D_MODEL)) * (0.5 * D_MODEL ** -0.5),
        'b_ada': 0.02 * n(ks[5], (DEPTH, 3 * D_MODEL)),
        'g_norm': 1.0 + 0.02 * n(ks[6], (DEPTH, D_MODEL)),
        'w_in': n(ks[7], (DEPTH, D_MODEL, D_IN)) * D_MODEL ** -0.5,
        'lam_q1': 0.1 * n(ks[8], (DEPTH, A_HEAD_DIM)),
        'lam_k1': 0.1 * n(ks[9], (DEPTH, A_HEAD_DIM)),
        'lam_q2': 0.1 * n(ks[10], (DEPTH, A_HEAD_DIM)),
        'lam_k2': 0.1 * n(ks[11], (DEPTH, A_HEAD_DIM)),
        'g_subln': 1.0 + 0.02 * n(ks[12], (DEPTH, A_VDIM)),
        'w_short': n(ks[13], (DEPTH, SHORT_CONV, B_WIDTH)) * SHORT_CONV ** -0.5,
        'w_conf': n(ks[14], (DEPTH, CONF_CONV, C_WIDTH)) * CONF_CONV ** -0.5,
        'b_conf': 0.02 * n(ks[15], (DEPTH, C_WIDTH)),
        'g_conf_ln': 1.0 + 0.02 * n(ks[16], (DEPTH, C_WIDTH)),
        'b_conf_ln': 0.02 * n(ks[17], (DEPTH, C_WIDTH)),
        'w_out': n(ks[18], (DEPTH, D_MIX, D_MODEL)) * D_MIX ** -0.5,
        'g_final': 1.0 + 0.02 * n(ks[19], (D_MODEL,)),
    }


def reference(x, c, ctx, c_ctx, w_ada, b_ada, g_norm, w_in, lam_q1, lam_k1, lam_q2, lam_k2,
              g_subln, w_short, w_conf, b_conf, g_conf_ln, b_conf_ln, w_out, g_final):
    n_tok = x.shape[1]
    ROWS = n_tok // GRID_W
    cos, sin = axial_rope_tables(ROWS)
    f32 = jnp.float32
    for l in range(DEPTH):
        last = l == DEPTH - 1
        lam_init = 0.8 - 0.6 * math.exp(-0.3 * l)
        lam = (jnp.exp(jnp.sum(lam_q1[l].astype(f32) * lam_k1[l].astype(f32)))
               - jnp.exp(jnp.sum(lam_q2[l].astype(f32) * lam_k2[l].astype(f32))) + lam_init)

        sh, sc, gt = modulation(c, w_ada[l], b_ada[l])
        sh_c, sc_c, gt_c = modulation(c_ctx, w_ada[l], b_ada[l])
        hx = rmsnorm(x, g_norm[l]) * (1.0 + sc[:, None, :]) + sh[:, None, :]
        hc = rmsnorm(ctx, g_norm[l]) * (1.0 + sc_c) + sh_c

        qx, kx, vx, gax, bbx, bcx, bhx, gbx, cax, cbx, gcx = split_columns(hx @ w_in[l])
        if not last:
            qc, kc, vc, gac, bbc, bcc, bhc, gbc, cac, cbc, gcc = split_columns(hc @ w_in[l])
        else:
            kc = hc @ w_in[l][:, K_OFF:V_OFF]
            vc = hc @ w_in[l][:, V_OFF:GA_OFF]
        kc_h, vc_h = heads_qk(kc), heads_v(vc)

        qx_h = apply_axial_rope(heads_qk(qx), cos, sin)
        kx_h = apply_axial_rope(heads_qk(kx), cos, sin)
        k_all = jnp.concatenate([kc_h, kx_h], axis=1)
        v_all = jnp.concatenate([vc_h, heads_v(vx)], axis=1)
        ya = attn_group_out(latent_diff_attention(qx_h, k_all, v_all, lam), gax, g_subln[l], lam_init)
        yb, yc = conv_groups_out(bbx, bcx, bhx, gbx, cax, cbx, gcx, w_short[l], w_conf[l],
                                 b_conf[l], g_conf_ln[l], b_conf_ln[l])
        y = jnp.concatenate([ya, yb, yc], axis=-1) @ w_out[l]

        if not last:
            ya_c = attn_group_out(diff_attend(heads_qk(qc), kc_h, vc_h, lam), gac, g_subln[l], lam_init)
            yb_c, yc_c = conv_groups_out(bbc, bcc, bhc, gbc, cac, cbc, gcc, w_short[l], w_conf[l],
                                         b_conf[l], g_conf_ln[l], b_conf_ln[l])
            y_c = jnp.concatenate([ya_c, yb_c, yc_c], axis=-1) @ w_out[l]
            ctx = ctx + gt_c * y_c
        x = x + gt[:, None, :] * y
    return rmsnorm(x, g_final)
```

```cpp
#include <hip/hip_runtime.h>
#include <stdint.h>
#include <stdio.h>

typedef unsigned short bf16_t;
typedef short bf16x8 __attribute__((ext_vector_type(8)));
typedef float f32x16 __attribute__((ext_vector_type(16)));
typedef float f32x4 __attribute__((ext_vector_type(4)));

constexpr int NB = 8, SEQ = 4096, DM = 1024, NL = 2, CTX = 256, DIN = 3840;
constexpr int NLAT = NB * SEQ;
constexpr int NCTX = NB * CTX;
constexpr int MROWS = NLAT + NCTX;
constexpr int KEYS = CTX + SEQ;
constexpr int GW = 2304;
constexpr float EPS = 1e-6f;
constexpr float C2 = 0.125f * 1.4426950408889634f;

constexpr size_t MiB = 1u << 20;
constexpr size_t WS_CTL = 0;
constexpr size_t WS_MOD = 1 * MiB;
constexpr size_t WS_ROPE = WS_MOD + 512 * 1024;
constexpr size_t WS_WIN = 2 * MiB;
constexpr size_t WS_WOUT = 18 * MiB;
constexpr size_t WS_H = 22 * MiB;
constexpr size_t WS_QB = 94 * MiB;
constexpr size_t WS_KB = 130 * MiB;
constexpr size_t WS_VB = 164 * MiB;
constexpr size_t WS_GB = 198 * MiB;
constexpr size_t WS_CTX1 = 360 * MiB;
constexpr size_t WS_AT = 368 * MiB;
constexpr size_t WS_END = 440 * MiB;

__device__ __forceinline__ float bf2f(bf16_t v) { return __uint_as_float((unsigned)v << 16); }
__device__ __forceinline__ bf16_t f2bf(float f) { unsigned u = __float_as_uint(f); return (bf16_t)((u + 0x7fffu + ((u >> 16) & 1u)) >> 16); }
__device__ __forceinline__ float silu_f(float x) { return x / (1.f + __expf(-x)); }
__device__ __forceinline__ float sigmoid_f(float x) { return 1.f / (1.f + __expf(-x)); }
__device__ __forceinline__ float wave_sum(float v) {
#pragma unroll
    for (int o = 1; o < 64; o <<= 1) v += __shfl_xor(v, o);
    return v;
}

__global__ void __launch_bounds__(256) k_transpose(const float* __restrict__ W, bf16_t* __restrict__ WT, int K, int N) {
    __shared__ float t[32][33];
    const int n0 = blockIdx.x * 32, k0 = blockIdx.y * 32, tx = threadIdx.x & 31, ty = threadIdx.x >> 5;
    for (int i = ty; i < 32; i += 8) t[i][tx] = W[(size_t)(k0 + i) * N + n0 + tx];
    __syncthreads();
    for (int i = ty; i < 32; i += 8) WT[(size_t)(n0 + i) * K + k0 + tx] = f2bf(t[tx][i]);
}

__global__ void __launch_bounds__(256) k_mod(const float* __restrict__ c, const float* __restrict__ cctx, const float* __restrict__ w_ada,
                                             const float* __restrict__ b_ada, float* __restrict__ MOD) {
    __shared__ float s[9][1024];
    __shared__ float red[4][9][64];
    const int l = blockIdx.y, n = blockIdx.x * 64 + (threadIdx.x & 63), kq = threadIdx.x >> 6;
    for (int i = threadIdx.x; i < 9 * 1024; i += 256) { const int r = i >> 10, k = i & 1023; const float v = r < 8 ? c[r * 1024 + k] : cctx[k]; s[r][k] = silu_f(v); }
    __syncthreads();
    float acc[9];
#pragma unroll
    for (int r = 0; r < 9; ++r) acc[r] = 0.f;
    const float* w = w_ada + (size_t)l * 1024 * 3072 + n;
    for (int k = kq * 256; k < kq * 256 + 256; ++k) { const float wv = w[(size_t)k * 3072];
#pragma unroll
        for (int r = 0; r < 9; ++r) acc[r] += s[r][k] * wv; }
#pragma unroll
    for (int r = 0; r < 9; ++r) red[kq][r][threadIdx.x & 63] = acc[r];
    __syncthreads();
    if (kq == 0) {
#pragma unroll
        for (int r = 0; r < 9; ++r) { const int j = threadIdx.x & 63; const float v = (red[0][r][j] + red[1][r][j]) + (red[2][r][j] + red[3][r][j]);
            MOD[((size_t)l * 9 + r) * 3072 + n] = v + b_ada[l * 3072 + n]; }
    }
}

__global__ void k_rope(float2* __restrict__ tab) {
    const int i = threadIdx.x + blockIdx.x * blockDim.x; if (i >= 1024) return;
    const int pos = i >> 4, f = i & 15;
    double inv = 1.0; for (int j = 0; j < f; ++j) inv *= 0.5623413251903491;
    const double ang = (double)pos * inv;
    const double hp = 1.5707963267948966;
    const double kq = __builtin_floor(ang / hp + 0.5); const double r = ang - kq * hp - kq * 6.123233995736766e-17;
    const double r2 = r * r;
    double sn = r * (1.0 + r2 * (-1.0 / 6 + r2 * (1.0 / 120 + r2 * (-1.0 / 5040 + r2 * (1.0 / 362880 + r2 * (-1.0 / 39916800 + r2 * (1.0 / 6227020800.0 + r2 * (-1.0 / 1307674368000.0))))))));
    double cs = 1.0 + r2 * (-0.5 + r2 * (1.0 / 24 + r2 * (-1.0 / 720 + r2 * (1.0 / 40320 + r2 * (-1.0 / 3628800 + r2 * (1.0 / 479001600.0 + r2 * (-1.0 / 87178291200.0 + r2 * (1.0 / 20922789888000.0))))))));
    const int q = ((int)kq) & 3; double co, si;
    if (q == 0) { co = cs; si = sn; } else if (q == 1) { co = -sn; si = cs; } else if (q == 2) { co = -cs; si = -sn; } else { co = sn; si = -cs; }
    tab[i] = make_float2((float)co, (float)si);
}

__global__ void __launch_bounds__(256) k_normmod(const float* __restrict__ src, int nrows, int rows_per_batch, int is_ctx,
                                                 const float* __restrict__ g, const float* __restrict__ modl, bf16_t* __restrict__ H, int hrow0) {
    const int row = blockIdx.x * 4 + (threadIdx.x >> 6), lane = threadIdx.x & 63; if (row >= nrows) return;
    const int mrow = is_ctx ? 8 : row / rows_per_batch;
    const f32x4* xr = (const f32x4*)(src + (size_t)row * DM) + lane;
    f32x4 v[4]; float ss = 0.f;
#pragma unroll
    for (int j = 0; j < 4; ++j) { v[j] = xr[64 * j]; ss += (v[j].x * v[j].x + v[j].y * v[j].y) + (v[j].z * v[j].z + v[j].w * v[j].w); }
    const float rstd = 1.0f / sqrtf(wave_sum(ss) * (1.f / DM) + EPS);
    const float* sh = modl + (size_t)mrow * 3072; const float* sc = sh + 1024;
    bf16_t* o = H + (size_t)(hrow0 + row) * DM;
#pragma unroll
    for (int j = 0; j < 4; ++j) { const int k = 4 * lane + 256 * j;
        const f32x4 gg = *(const f32x4*)(g + k), s1 = *(const f32x4*)(sc + k), s0 = *(const f32x4*)(sh + k);
        ushort4 w; w.x = f2bf(v[j].x * rstd * gg.x * (1.f + s1.x) + s0.x); w.y = f2bf(v[j].y * rstd * gg.y * (1.f + s1.y) + s0.y);
        w.z = f2bf(v[j].z * rstd * gg.z * (1.f + s1.z) + s0.z); w.w = f2bf(v[j].w * rstd * gg.w * (1.f + s1.w) + s0.w);
        *(ushort4*)(o + k) = w; }
}

struct InProjOut { bf16_t* QB; bf16_t* KB; bf16_t* VB; bf16_t* GB; const float2* rope; };
__device__ __forceinline__ void inproj_store4(const InProjOut& P, int hr, int n, float v0, float v1, float v2, float v3) {
    const bool lat = hr < NLAT; int b, t;
    if (lat) { b = hr >> 12; t = hr & 4095; } else { const int c = hr - NLAT; b = c >> 8; t = c & 255; }
    bf16_t* dst;
    if (n < 1024) {
        if (lat) {
            const int i0 = (n & 63) >> 1;
            { const int i = i0; const int pos = (i < 16) ? (t >> 6) : (t & 63); const float2 cs = P.rope[pos * 16 + (i & 15)];
              const float a = v0, bq = v1; v0 = a * cs.x - bq * cs.y; v1 = a * cs.y + bq * cs.x; }
            { const int i = i0 + 1; const int pos = (i < 16) ? (t >> 6) : (t & 63); const float2 cs = P.rope[pos * 16 + (i & 15)];
              const float a = v2, bq = v3; v2 = a * cs.x - bq * cs.y; v3 = a * cs.y + bq * cs.x; }
        }
        if (n < 512) { v0 *= C2; v1 *= C2; v2 *= C2; v3 *= C2; dst = P.QB + (size_t)hr * 512 + n; }
        else { const int kr = b * KEYS + (lat ? CTX + t : t); dst = P.KB + (size_t)kr * 512 + (n - 512); }
    } else if (n < 1536) { const int kr = b * KEYS + (lat ? CTX + t : t); dst = P.VB + (size_t)kr * 512 + (n - 1024); }
    else dst = P.GB + (size_t)hr * GW + (n - 1536);
    ushort4 w; w.x = f2bf(v0); w.y = f2bf(v1); w.z = f2bf(v2); w.w = f2bf(v3);
    *(ushort4*)dst = w;
}

__global__ void __launch_bounds__(64) k_gemm_in(const bf16_t* __restrict__ H, const bf16_t* __restrict__ WT, InProjOut P, int mrow0) {
    const int lane = threadIdx.x, r32 = lane & 31, hi = lane >> 5;
    const int n0 = blockIdx.x * 128, m0 = mrow0 + blockIdx.y * 32;
    f32x16 acc[4];
#pragma unroll
    for (int i = 0; i < 4; ++i) acc[i] = f32x16{};
    const bf16_t* hp = H + (size_t)(m0 + r32) * DM + hi * 8;
    const bf16_t* wp = WT + (size_t)(n0 + r32) * DM + hi * 8;
    for (int k = 0; k < DM; k += 16) {
        const bf16x8 bfr = *(const bf16x8*)(hp + k);
#pragma unroll
        for (int nb = 0; nb < 4; ++nb) { const bf16x8 afr = *(const bf16x8*)(wp + (size_t)nb * 32 * DM + k);
            acc[nb] = __builtin_amdgcn_mfma_f32_32x32x16_bf16(afr, bfr, acc[nb], 0, 0, 0); }
    }
#pragma unroll
    for (int nb = 0; nb < 4; ++nb)
#pragma unroll
        for (int g = 0; g < 4; ++g) inproj_store4(P, m0 + r32, n0 + 32 * nb + 8 * g + 4 * hi, acc[nb][4 * g], acc[nb][4 * g + 1], acc[nb][4 * g + 2], acc[nb][4 * g + 3]);
}

__global__ void __launch_bounds__(128) k_attn_naive(const bf16_t* __restrict__ QB, const bf16_t* __restrict__ KB, const bf16_t* __restrict__ VB,
                                                    const bf16_t* __restrict__ GB, bf16_t* __restrict__ AT, const float* __restrict__ lq1, const float* __restrict__ lk1,
                                                    const float* __restrict__ lq2, const float* __restrict__ lk2, const float* __restrict__ gsub, int layer, int is_ctx) {
    __shared__ float sh[64][129];
    const int q = threadIdx.x & 63, m = __builtin_amdgcn_readfirstlane(threadIdx.x >> 6);
    const int h = blockIdx.y, b = blockIdx.z;
    const int hr = is_ctx ? NLAT + b * CTX + blockIdx.x * 64 + q : b * SEQ + blockIdx.x * 64 + q;
    const int nkeys = is_ctx ? CTX : KEYS;
    float qv[64];
    { const bf16_t* qp = QB + (size_t)hr * 512 + h * 128 + m * 64;
#pragma unroll
      for (int d = 0; d < 64; d += 8) { const uint4 u = *(const uint4*)(qp + d); const unsigned w[4] = {u.x, u.y, u.z, u.w};
#pragma unroll
          for (int e = 0; e < 4; ++e) { qv[d + 2 * e] = __uint_as_float(w[e] << 16); qv[d + 2 * e + 1] = __uint_as_float(w[e] & 0xffff0000u); } } }
    const bf16_t* kbase = KB + (size_t)b * KEYS * 512 + h * 128 + m * 64;
    const bf16_t* vbase = VB + (size_t)b * KEYS * 512 + h * 128;
    float mx = -3.0e38f;
    for (int j = 0; j < nkeys; ++j) {
        const uint4* kp = (const uint4*)(kbase + (size_t)j * 512); float s = 0.f;
#pragma unroll
        for (int c = 0; c < 8; ++c) { const uint4 u = kp[c]; const unsigned w[4] = {u.x, u.y, u.z, u.w};
#pragma unroll
            for (int e = 0; e < 4; ++e) { s += qv[8 * c + 2 * e] * __uint_as_float(w[e] << 16); s += qv[8 * c + 2 * e + 1] * __uint_as_float(w[e] & 0xffff0000u); } }
        mx = fmaxf(mx, s);
    }
    float o[128], l = 0.f;
#pragma unroll
    for (int d = 0; d < 128; ++d) o[d] = 0.f;
    for (int j = 0; j < nkeys; ++j) {
        const uint4* kp = (const uint4*)(kbase + (size_t)j * 512); float s = 0.f;
#pragma unroll
        for (int c = 0; c < 8; ++c) { const uint4 u = kp[c]; const unsigned w[4] = {u.x, u.y, u.z, u.w};
#pragma unroll
            for (int e = 0; e < 4; ++e) { s += qv[8 * c + 2 * e] * __uint_as_float(w[e] << 16); s += qv[8 * c + 2 * e + 1] * __uint_as_float(w[e] & 0xffff0000u); } }
        const float p = __builtin_amdgcn_exp2f(s - mx); l += p;
        const uint4* vp = (const uint4*)(vbase + (size_t)j * 512);
#pragma unroll
        for (int c = 0; c < 16; ++c) { const uint4 u = vp[c]; const unsigned w[4] = {u.x, u.y, u.z, u.w};
#pragma unroll
            for (int e = 0; e < 4; ++e) { o[8 * c + 2 * e] += p * __uint_as_float(w[e] << 16); o[8 * c + 2 * e + 1] += p * __uint_as_float(w[e] & 0xffff0000u); } }
    }
    const float rl = 1.f / l;
    if (m == 1) {
#pragma unroll
        for (int d = 0; d < 128; ++d) sh[q][d] = o[d] * rl;
    }
    __syncthreads();
    if (m == 0) {
        float s1 = 0.f, s2 = 0.f;
        for (int d = 0; d < 64; ++d) { s1 += lq1[layer * 64 + d] * lk1[layer * 64 + d]; s2 += lq2[layer * 64 + d] * lk2[layer * 64 + d]; }
        const float lam_init = 0.8f - 0.6f * expf(-0.3f * (float)layer);
        const float lam = expf(s1) - expf(s2) + lam_init;
        float ss = 0.f;
#pragma unroll
        for (int d = 0; d < 128; ++d) { o[d] = o[d] * rl - lam * sh[q][d]; ss += o[d] * o[d]; }
        const float r = 1.0f / sqrtf(ss * (1.f / 128.f) + EPS) * (1.f - lam_init);
        const bf16_t* ga = GB + (size_t)hr * GW + h * 128;
        bf16_t* at = AT + (size_t)hr * DM + h * 128;
#pragma unroll
        for (int d = 0; d < 128; ++d) at[d] = f2bf(o[d] * r * gsub[layer * 128 + d] * silu_f(bf2f(ga[d])));
    }
}

__global__ void __launch_bounds__(256) k_conv(const bf16_t* __restrict__ GB, bf16_t* __restrict__ AT, const float* __restrict__ w_short, const float* __restrict__ w_conf,
                                              const float* __restrict__ b_conf, const float* __restrict__ g_ln, const float* __restrict__ b_ln, int layer, int hr0) {
    __shared__ float red[8];
    const int hr = hr0 + blockIdx.x, c = threadIdx.x;
    int t, len; if (hr < NLAT) { t = hr & 4095; len = SEQ; } else { t = (hr - NLAT) & 255; len = CTX; }
    const bf16_t* G = GB + (size_t)hr * GW;
    float accb = 0.f;
#pragma unroll
    for (int j = 0; j < 3; ++j) { const int tt = t + j - 1; if (tt >= 0 && tt < len) { const bf16_t* Gt = G + (ptrdiff_t)(j - 1) * GW; accb += w_short[(layer * 3 + j) * 256 + c] * (bf2f(Gt[768 + c]) * bf2f(Gt[1024 + c])); } }
    const float yb = bf2f(G[512 + c]) * accb * silu_f(bf2f(G[1280 + c]));
    float acc = b_conf[layer * 256 + c];
    for (int j = 0; j < 31; ++j) { const int tt = t + j - 15; if (tt >= 0 && tt < len) { const bf16_t* Gt = G + (ptrdiff_t)(j - 15) * GW;
        acc += w_conf[(layer * 31 + j) * 256 + c] * (bf2f(Gt[1536 + c]) * sigmoid_f(bf2f(Gt[1792 + c]))); } }
    float s = wave_sum(acc); if ((c & 63) == 0) red[c >> 6] = s; __syncthreads();
    const float mean = (red[0] + red[1] + red[2] + red[3]) * (1.f / 256.f);
    const float dv = acc - mean; float s2 = wave_sum(dv * dv); if ((c & 63) == 0) red[4 + (c >> 6)] = s2; __syncthreads();
    const float var = (red[4] + red[5] + red[6] + red[7]) * (1.f / 256.f);
    const float y = dv * (1.0f / sqrtf(var + EPS)) * g_ln[layer * 256 + c] + b_ln[layer * 256 + c];
    const float yc = silu_f(y) * silu_f(bf2f(G[2048 + c]));
    AT[(size_t)hr * DM + 512 + c] = f2bf(yb); AT[(size_t)hr * DM + 768 + c] = f2bf(yc);
}

__global__ void __launch_bounds__(64) k_gemm_out(const bf16_t* __restrict__ AT, const bf16_t* __restrict__ WT, const float* xin, float* xout,
                                                 const float* __restrict__ modl, int hrow0, int rows_per_batch, int is_ctx) {
    const int lane = threadIdx.x, r32 = lane & 31, hi = lane >> 5;
    const int n0 = blockIdx.x * 128, m0 = blockIdx.y * 32;
    f32x16 acc[4];
#pragma unroll
    for (int i = 0; i < 4; ++i) acc[i] = f32x16{};
    const bf16_t* hp = AT + (size_t)(hrow0 + m0 + r32) * DM + hi * 8;
    const bf16_t* wp = WT + (size_t)(n0 + r32) * DM + hi * 8;
    for (int k = 0; k < DM; k += 16) {
        const bf16x8 bfr = *(const bf16x8*)(hp + k);
#pragma unroll
        for (int nb = 0; nb < 4; ++nb) { const bf16x8 afr = *(const bf16x8*)(wp + (size_t)nb * 32 * DM + k);
            acc[nb] = __builtin_amdgcn_mfma_f32_32x32x16_bf16(afr, bfr, acc[nb], 0, 0, 0); }
    }
    const int row = m0 + r32, mrow = is_ctx ? 8 : row / rows_per_batch;
    const float* gt = modl + (size_t)mrow * 3072 + 2048;
#pragma unroll
    for (int nb = 0; nb < 4; ++nb)
#pragma unroll
        for (int g = 0; g < 4; ++g) { const int n = n0 + 32 * nb + 8 * g + 4 * hi;
            const f32x4 xv = *(const f32x4*)(xin + (size_t)row * DM + n), gv = *(const f32x4*)(gt + n);
            f32x4 o; o.x = xv.x + gv.x * acc[nb][4 * g]; o.y = xv.y + gv.y * acc[nb][4 * g + 1]; o.z = xv.z + gv.z * acc[nb][4 * g + 2]; o.w = xv.w + gv.w * acc[nb][4 * g + 3];
            *(f32x4*)(xout + (size_t)row * DM + n) = o; }
}

__global__ void __launch_bounds__(256) k_final(float* __restrict__ x, const float* __restrict__ g, int nrows) {
    const int row = blockIdx.x * 4 + (threadIdx.x >> 6), lane = threadIdx.x & 63; if (row >= nrows) return;
    f32x4* xr = (f32x4*)(x + (size_t)row * DM) + lane;
    f32x4 v[4]; float ss = 0.f;
#pragma unroll
    for (int j = 0; j < 4; ++j) { v[j] = xr[64 * j]; ss += (v[j].x * v[j].x + v[j].y * v[j].y) + (v[j].z * v[j].z + v[j].w * v[j].w); }
    const float rstd = 1.0f / sqrtf(wave_sum(ss) * (1.f / DM) + EPS);
#pragma unroll
    for (int j = 0; j < 4; ++j) { const f32x4 gg = *(const f32x4*)(g + 4 * lane + 256 * j); f32x4 o = v[j] * rstd; o.x *= gg.x; o.y *= gg.y; o.z *= gg.z; o.w *= gg.w; xr[64 * j] = o; }
}

extern "C" void kernel_launch(void* const* d_in, const int* in_sizes, int n_in, void* d_out, int out_size, void* d_ws, size_t ws_size, hipStream_t stream) {
    if (n_in != 20 || in_sizes[0] != NLAT * DM || out_size != NLAT * DM || ws_size < WS_END) {
        fprintf(stderr, "kernel_launch: unexpected shapes (n_in %d in0 %d out %d ws %zu)\n", n_in, n_in > 0 ? in_sizes[0] : -1, out_size, ws_size); return; }
    const float* x = (const float*)d_in[0]; const float* c = (const float*)d_in[1]; const float* ctx = (const float*)d_in[2]; const float* cctx = (const float*)d_in[3];
    const float* w_ada = (const float*)d_in[4]; const float* b_ada = (const float*)d_in[5]; const float* g_norm = (const float*)d_in[6]; const float* w_in = (const float*)d_in[7];
    const float* lq1 = (const float*)d_in[8]; const float* lk1 = (const float*)d_in[9]; const float* lq2 = (const float*)d_in[10]; const float* lk2 = (const float*)d_in[11];
    const float* gsub = (const float*)d_in[12]; const float* w_short = (const float*)d_in[13]; const float* w_conf = (const float*)d_in[14]; const float* b_conf = (const float*)d_in[15];
    const float* g_ln = (const float*)d_in[16]; const float* b_ln = (const float*)d_in[17]; const float* w_out = (const float*)d_in[18]; const float* g_final = (const float*)d_in[19];
    unsigned char* ws = (unsigned char*)d_ws; float* out = (float*)d_out;
    float* MOD = (float*)(ws + WS_MOD); float2* ROPE = (float2*)(ws + WS_ROPE);
    bf16_t* WIN = (bf16_t*)(ws + WS_WIN); bf16_t* WOUT = (bf16_t*)(ws + WS_WOUT); bf16_t* H = (bf16_t*)(ws + WS_H);
    bf16_t* QB = (bf16_t*)(ws + WS_QB); bf16_t* KB = (bf16_t*)(ws + WS_KB); bf16_t* VB = (bf16_t*)(ws + WS_VB); bf16_t* GB = (bf16_t*)(ws + WS_GB);
    float* CTX1 = (float*)(ws + WS_CTX1); bf16_t* AT = (bf16_t*)(ws + WS_AT);
    for (int l = 0; l < NL; ++l) {
        k_transpose<<<dim3(DIN / 32, DM / 32), 256, 0, stream>>>(w_in + (size_t)l * DM * DIN, WIN + (size_t)l * DIN * DM, DM, DIN);
        k_transpose<<<dim3(DM / 32, DM / 32), 256, 0, stream>>>(w_out + (size_t)l * DM * DM, WOUT + (size_t)l * DM * DM, DM, DM);
    }
    k_mod<<<dim3(3072 / 64, NL), 256, 0, stream>>>(c, cctx, w_ada, b_ada, MOD);
    k_rope<<<4, 256, 0, stream>>>(ROPE);
    InProjOut P{QB, KB, VB, GB, ROPE};
    for (int l = 0; l < NL; ++l) {
        const float* xin = l == 0 ? x : out; const float* cin = l == 0 ? ctx : CTX1; const float* modl = MOD + (size_t)l * 9 * 3072;
        k_normmod<<<NLAT / 4, 256, 0, stream>>>(xin, NLAT, SEQ, 0, g_norm + l * DM, modl, H, 0);
        k_normmod<<<NCTX / 4, 256, 0, stream>>>(cin, NCTX, CTX, 1, g_norm + l * DM, modl, H, NLAT);
        k_gemm_in<<<dim3(DIN / 128, MROWS / 32), 64, 0, stream>>>(H, WIN + (size_t)l * DIN * DM, P, 0);
        k_attn_naive<<<dim3(SEQ / 64, 4, NB), 128, 0, stream>>>(QB, KB, VB, GB, AT, lq1, lk1, lq2, lk2, gsub, l, 0);
        k_conv<<<NLAT, 256, 0, stream>>>(GB, AT, w_short, w_conf, b_conf, g_ln, b_ln, l, 0);
        if (l == 0) {
            k_attn_naive<<<dim3(CTX / 64, 4, NB), 128, 0, stream>>>(QB, KB, VB, GB, AT, lq1, lk1, lq2, lk2, gsub, l, 1);
            k_conv<<<NCTX, 256, 0, stream>>>(GB, AT, w_short, w_conf, b_conf, g_ln, b_ln, l, NLAT);
            k_gemm_out<<<dim3(DM / 128, NCTX / 32), 64, 0, stream>>>(AT, WOUT + (size_t)l * DM * DM, ctx, CTX1, modl, NLAT, CTX, 1);
        }
        k_gemm_out<<<dim3(DM / 128, NLAT / 32), 64, 0, stream>>>(AT, WOUT + (size_t)l * DM * DM, xin, out, modl, 0, SEQ, 0);
    }
    k_final<<<NLAT / 4, 256, 0, stream>>>(out, g_final, NLAT);
}
```

```cpp
#include <hip/hip_runtime.h>
#include <stdint.h>
#include <stdio.h>

typedef unsigned short bf16_t;
typedef short bf16x8 __attribute__((ext_vector_type(8)));
typedef float f32x16 __attribute__((ext_vector_type(16)));
typedef float f32x4 __attribute__((ext_vector_type(4)));

constexpr int NB = 8, SEQ = 4096, DM = 1024, NL = 2, CTX = 256, DIN = 3840;
constexpr int NLAT = NB * SEQ;
constexpr int NCTX = NB * CTX;
constexpr int MROWS = NLAT + NCTX;
constexpr int KEYS = CTX + SEQ;
constexpr int GW = 2304;
constexpr float EPS = 1e-6f;
constexpr float C2 = 0.125f * 1.4426950408889634f;

constexpr size_t MiB = 1u << 20;
constexpr size_t WS_CTL = 0;
constexpr size_t WS_MOD = 1 * MiB;
constexpr size_t WS_ROPE = WS_MOD + 512 * 1024;
constexpr size_t WS_WIN = 2 * MiB;
constexpr size_t WS_WOUT = 18 * MiB;
constexpr size_t WS_H = 22 * MiB;
constexpr size_t WS_QB = 94 * MiB;
constexpr size_t WS_KB = 130 * MiB;
constexpr size_t WS_VB = 164 * MiB;
constexpr size_t WS_GB = 198 * MiB;
constexpr size_t WS_CTX1 = 360 * MiB;
constexpr size_t WS_AT = 368 * MiB;
constexpr size_t WS_END = 440 * MiB;

__device__ __forceinline__ float bf2f(bf16_t v) { return __uint_as_float((unsigned)v << 16); }
__device__ __forceinline__ bf16_t f2bf(float f) { unsigned u = __float_as_uint(f); return (bf16_t)((u + 0x7fffu + ((u >> 16) & 1u)) >> 16); }
__device__ __forceinline__ float silu_f(float x) { return x / (1.f + __expf(-x)); }
__device__ __forceinline__ float sigmoid_f(float x) { return 1.f / (1.f + __expf(-x)); }
__device__ __forceinline__ float wave_sum(float v) {
#pragma unroll
    for (int o = 1; o < 64; o <<= 1) v += __shfl_xor(v, o);
    return v;
}

__global__ void __launch_bounds__(256) k_transpose(const float* __restrict__ W, bf16_t* __restrict__ WT, int K, int N) {
    __shared__ float t[32][33];
    const int n0 = blockIdx.x * 32, k0 = blockIdx.y * 32, tx = threadIdx.x & 31, ty = threadIdx.x >> 5;
    for (int i = ty; i < 32; i += 8) t[i][tx] = W[(size_t)(k0 + i) * N + n0 + tx];
    __syncthreads();
    for (int i = ty; i < 32; i += 8) WT[(size_t)(n0 + i) * K + k0 + tx] = f2bf(t[tx][i]);
}

__global__ void __launch_bounds__(256) k_mod(const float* __restrict__ c, const float* __restrict__ cctx, const float* __restrict__ w_ada,
                                             const float* __restrict__ b_ada, float* __restrict__ MOD) {
    __shared__ float s[9][1024];
    __shared__ float red[4][9][64];
    const int l = blockIdx.y, n = blockIdx.x * 64 + (threadIdx.x & 63), kq = threadIdx.x >> 6;
    for (int i = threadIdx.x; i < 9 * 1024; i += 256) { const int r = i >> 10, k = i & 1023; const float v = r < 8 ? c[r * 1024 + k] : cctx[k]; s[r][k] = silu_f(v); }
    __syncthreads();
    float acc[9];
#pragma unroll
    for (int r = 0; r < 9; ++r) acc[r] = 0.f;
    const float* w = w_ada + (size_t)l * 1024 * 3072 + n;
    for (int k = kq * 256; k < kq * 256 + 256; ++k) { const float wv = w[(size_t)k * 3072];
#pragma unroll
        for (int r = 0; r < 9; ++r) acc[r] += s[r][k] * wv; }
#pragma unroll
    for (int r = 0; r < 9; ++r) red[kq][r][threadIdx.x & 63] = acc[r];
    __syncthreads();
    if (kq == 0) {
#pragma unroll
        for (int r = 0; r < 9; ++r) { const int j = threadIdx.x & 63; const float v = (red[0][r][j] + red[1][r][j]) + (red[2][r][j] + red[3][r][j]);
            MOD[((size_t)l * 9 + r) * 3072 + n] = v + b_ada[l * 3072 + n]; }
    }
}

__global__ void k_rope(float2* __restrict__ tab) {
    const int i = threadIdx.x + blockIdx.x * blockDim.x; if (i >= 1024) return;
    const int pos = i >> 4, f = i & 15;
    double inv = 1.0; for (int j = 0; j < f; ++j) inv *= 0.5623413251903491;
    const double ang = (double)pos * inv;
    const double hp = 1.5707963267948966;
    const double kq = __builtin_floor(ang / hp + 0.5); const double r = ang - kq * hp - kq * 6.123233995736766e-17;
    const double r2 = r * r;
    double sn = r * (1.0 + r2 * (-1.0 / 6 + r2 * (1.0 / 120 + r2 * (-1.0 / 5040 + r2 * (1.0 / 362880 + r2 * (-1.0 / 39916800 + r2 * (1.0 / 6227020800.0 + r2 * (-1.0 / 1307674368000.0))))))));
    double cs = 1.0 + r2 * (-0.5 + r2 * (1.0 / 24 + r2 * (-1.0 / 720 + r2 * (1.0 / 40320 + r2 * (-1.0 / 3628800 + r2 * (1.0 / 479001600.0 + r2 * (-1.0 / 87178291200.0 + r2 * (1.0 / 20922789888000.0))))))));
    const int q = ((int)kq) & 3; double co, si;
    if (q == 0) { co = cs; si = sn; } else if (q == 1) { co = -sn; si = cs; } else if (q == 2) { co = -cs; si = -sn; } else { co = sn; si = -cs; }
    tab[i] = make_float2((float)co, (float)si);
}

__global__ void __launch_bounds__(256) k_normmod(const float* __restrict__ src, int nrows, int rows_per_batch, int is_ctx,
                                                 const float* __restrict__ g, const float* __restrict__ modl, bf16_t* __restrict__ H, int hrow0) {
    const int row = blockIdx.x * 4 + (threadIdx.x >> 6), lane = threadIdx.x & 63; if (row >= nrows) return;
    const int mrow = is_ctx ? 8 : row / rows_per_batch;
    const f32x4* xr = (const f32x4*)(src + (size_t)row * DM) + lane;
    f32x4 v[4]; float ss = 0.f;
#pragma unroll
    for (int j = 0; j < 4; ++j) { v[j] = xr[64 * j]; ss += (v[j].x * v[j].x + v[j].y * v[j].y) + (v[j].z * v[j].z + v[j].w * v[j].w); }
    const float rstd = 1.0f / sqrtf(wave_sum(ss) * (1.f / DM) + EPS);
    const float* sh = modl + (size_t)mrow * 3072; const float* sc = sh + 1024;
    bf16_t* o = H + (size_t)(hrow0 + row) * DM;
#pragma unroll
    for (int j = 0; j < 4; ++j) { const int k = 4 * lane + 256 * j;
        const f32x4 gg = *(const f32x4*)(g + k), s1 = *(const f32x4*)(sc + k), s0 = *(const f32x4*)(sh + k);
        ushort4 w; w.x = f2bf(v[j].x * rstd * gg.x * (1.f + s1.x) + s0.x); w.y = f2bf(v[j].y * rstd * gg.y * (1.f + s1.y) + s0.y);
        w.z = f2bf(v[j].z * rstd * gg.z * (1.f + s1.z) + s0.z); w.w = f2bf(v[j].w * rstd * gg.w * (1.f + s1.w) + s0.w);
        *(ushort4*)(o + k) = w; }
}

struct InProjOut { bf16_t* QB; bf16_t* KB; bf16_t* VB; bf16_t* GB; const float2* rope; };
__device__ __forceinline__ void inproj_store4(const InProjOut& P, int hr, int n, float v0, float v1, float v2, float v3) {
    const bool lat = hr < NLAT; int b, t;
    if (lat) { b = hr >> 12; t = hr & 4095; } else { const int c = hr - NLAT; b = c >> 8; t = c & 255; }
    bf16_t* dst;
    if (n < 1024) {
        if (lat) {
            const int i0 = (n & 63) >> 1;
            { const int i = i0; const int pos = (i < 16) ? (t >> 6) : (t & 63); const float2 cs = P.rope[pos * 16 + (i & 15)];
              const float a = v0, bq = v1; v0 = a * cs.x - bq * cs.y; v1 = a * cs.y + bq * cs.x; }
            { const int i = i0 + 1; const int pos = (i < 16) ? (t >> 6) : (t & 63); const float2 cs = P.rope[pos * 16 + (i & 15)];
              const float a = v2, bq = v3; v2 = a * cs.x - bq * cs.y; v3 = a * cs.y + bq * cs.x; }
        }
        if (n < 512) { v0 *= C2; v1 *= C2; v2 *= C2; v3 *= C2; dst = P.QB + (size_t)hr * 512 + n; }
        else { const int kr = b * KEYS + (lat ? CTX + t : t); dst = P.KB + (size_t)kr * 512 + (n - 512); }
    } else if (n < 1536) { const int kr = b * KEYS + (lat ? CTX + t : t); dst = P.VB + (size_t)kr * 512 + (n - 1024); }
    else dst = P.GB + (size_t)hr * GW + (n - 1536);
    ushort4 w; w.x = f2bf(v0); w.y = f2bf(v1); w.z = f2bf(v2); w.w = f2bf(v3);
    *(ushort4*)dst = w;
}

__global__ void __launch_bounds__(64) k_gemm_in(const bf16_t* __restrict__ H, const bf16_t* __restrict__ WT, InProjOut P, int mrow0) {
    const int lane = threadIdx.x, r32 = lane & 31, hi = lane >> 5;
    const int n0 = blockIdx.x * 128, m0 = mrow0 + blockIdx.y * 32;
    f32x16 acc[4];
#pragma unroll
    for (int i = 0; i < 4; ++i) acc[i] = f32x16{};
    const bf16_t* hp = H + (size_t)(m0 + r32) * DM + hi * 8;
    const bf16_t* wp = WT + (size_t)(n0 + r32) * DM + hi * 8;
    for (int k = 0; k < DM; k += 16) {
        const bf16x8 bfr = *(const bf16x8*)(hp + k);
#pragma unroll
        for (int nb = 0; nb < 4; ++nb) { const bf16x8 afr = *(const bf16x8*)(wp + (size_t)nb * 32 * DM + k);
            acc[nb] = __builtin_amdgcn_mfma_f32_32x32x16_bf16(afr, bfr, acc[nb], 0, 0, 0); }
    }
#pragma unroll
    for (int nb = 0; nb < 4; ++nb)
#pragma unroll
        for (int g = 0; g < 4; ++g) inproj_store4(P, m0 + r32, n0 + 32 * nb + 8 * g + 4 * hi, acc[nb][4 * g], acc[nb][4 * g + 1], acc[nb][4 * g + 2], acc[nb][4 * g + 3]);
}

__global__ void __launch_bounds__(128) k_attn_naive(const bf16_t* __restrict__ QB, const bf16_t* __restrict__ KB, const bf16_t* __restrict__ VB,
                                                    const bf16_t* __restrict__ GB, bf16_t* __restrict__ AT, const float* __restrict__ lq1, const float* __restrict__ lk1,
                                                    const float* __restrict__ lq2, const float* __restrict__ lk2, const float* __restrict__ gsub, int layer, int is_ctx) {
    __shared__ float sh[64][129];
    const int q = threadIdx.x & 63, m = __builtin_amdgcn_readfirstlane(threadIdx.x >> 6);
    const int h = blockIdx.y, b = blockIdx.z;
    const int hr = is_ctx ? NLAT + b * CTX + blockIdx.x * 64 + q : b * SEQ + blockIdx.x * 64 + q;
    const int nkeys = is_ctx ? CTX : KEYS;
    float qv[64];
    { const bf16_t* qp = QB + (size_t)hr * 512 + h * 128 + m * 64;
#pragma unroll
      for (int d = 0; d < 64; d += 8) { const uint4 u = *(const uint4*)(qp + d); const unsigned w[4] = {u.x, u.y, u.z, u.w};
#pragma unroll
          for (int e = 0; e < 4; ++e) { qv[d + 2 * e] = __uint_as_float(w[e] << 16); qv[d + 2 * e + 1] = __uint_as_float(w[e] & 0xffff0000u); } } }
    const bf16_t* kbase = KB + (size_t)b * KEYS * 512 + h * 128 + m * 64;
    const bf16_t* vbase = VB + (size_t)b * KEYS * 512 + h * 128;
    float mx = -3.0e38f;
    for (int j = 0; j < nkeys; ++j) {
        const uint4* kp = (const uint4*)(kbase + (size_t)j * 512); float s = 0.f;
#pragma unroll
        for (int c = 0; c < 8; ++c) { const uint4 u = kp[c]; const unsigned w[4] = {u.x, u.y, u.z, u.w};
#pragma unroll
            for (int e = 0; e < 4; ++e) { s += qv[8 * c + 2 * e] * __uint_as_float(w[e] << 16); s += qv[8 * c + 2 * e + 1] * __uint_as_float(w[e] & 0xffff0000u); } }
        mx = fmaxf(mx, s);
    }
    float o[128], l = 0.f;
#pragma unroll
    for (int d = 0; d < 128; ++d) o[d] = 0.f;
    for (int j = 0; j < nkeys; ++j) {
        const uint4* kp = (const uint4*)(kbase + (size_t)j * 512); float s = 0.f;
#pragma unroll
        for (int c = 0; c < 8; ++c) { const uint4 u = kp[c]; const unsigned w[4] = {u.x, u.y, u.z, u.w};
#pragma unroll
            for (int e = 0; e < 4; ++e) { s += qv[8 * c + 2 * e] * __uint_as_float(w[e] << 16); s += qv[8 * c + 2 * e + 1] * __uint_as_float(w[e] & 0xffff0000u); } }
        const float p = __builtin_amdgcn_exp2f(s - mx); l += p;
        const uint4* vp = (const uint4*)(vbase + (size_t)j * 512);
#pragma unroll
        for (int c = 0; c < 16; ++c) { const uint4 u = vp[c]; const unsigned w[4] = {u.x, u.y, u.z, u.w};
#pragma unroll
            for (int e = 0; e < 4; ++e) { o[8 * c + 2 * e] += p * __uint_as_float(w[e] << 16); o[8 * c + 2 * e + 1] += p * __uint_as_float(w[e] & 0xffff0000u); } }
    }
    const float rl = 1.f / l;
    if (m == 1) {
#pragma unroll
        for (int d = 0; d < 128; ++d) sh[q][d] = o[d] * rl;
    }
    __syncthreads();
    if (m == 0) {
        float s1 = 0.f, s2 = 0.f;
        for (int d = 0; d < 64; ++d) { s1 += lq1[layer * 64 + d] * lk1[layer * 64 + d]; s2 += lq2[layer * 64 + d] * lk2[layer * 64 + d]; }
        const float lam_init = 0.8f - 0.6f * expf(-0.3f * (float)layer);
        const float lam = expf(s1) - expf(s2) + lam_init;
        float ss = 0.f;
#pragma unroll
        for (int d = 0; d < 128; ++d) { o[d] = o[d] * rl - lam * sh[q][d]; ss += o[d] * o[d]; }
        const float r = 1.0f / sqrtf(ss * (1.f / 128.f) + EPS) * (1.f - lam_init);
        const bf16_t* ga = GB + (size_t)hr * GW + h * 128;
        bf16_t* at = AT + (size_t)hr * DM + h * 128;
#pragma unroll
        for (int d = 0; d < 128; ++d) at[d] = f2bf(o[d] * r * gsub[layer * 128 + d] * silu_f(bf2f(ga[d])));
    }
}

__global__ void __launch_bounds__(256) k_conv(const bf16_t* __restrict__ GB, bf16_t* __restrict__ AT, const float* __restrict__ w_short, const float* __restrict__ w_conf,
                                              const float* __restrict__ b_conf, const float* __restrict__ g_ln, const float* __restrict__ b_ln, int layer, int hr0) {
    __shared__ float red[8];
    const int hr = hr0 + blockIdx.x, c = threadIdx.x;
    int t, len; if (hr < NLAT) { t = hr & 4095; len = SEQ; } else { t = (hr - NLAT) & 255; len = CTX; }
    const bf16_t* G = GB + (size_t)hr * GW;
    float accb = 0.f;
#pragma unroll
    for (int j = 0; j < 3; ++j) { const int tt = t + j - 1; if (tt >= 0 && tt < len) { const bf16_t* Gt = G + (ptrdiff_t)(j - 1) * GW; accb += w_short[(layer * 3 + j) * 256 + c] * (bf2f(Gt[768 + c]) * bf2f(Gt[1024 + c])); } }
    const float yb = bf2f(G[512 + c]) * accb * silu_f(bf2f(G[1280 + c]));
    float acc = b_conf[layer * 256 + c];
    for (int j = 0; j < 31; ++j) { const int tt = t + j - 15; if (tt >= 0 && tt < len) { const bf16_t* Gt = G + (ptrdiff_t)(j - 15) * GW;
        acc += w_conf[(layer * 31 + j) * 256 + c] * (bf2f(Gt[1536 + c]) * sigmoid_f(bf2f(Gt[1792 + c]))); } }
    float s = wave_sum(acc); if ((c & 63) == 0) red[c >> 6] = s; __syncthreads();
    const float mean = (red[0] + red[1] + red[2] + red[3]) * (1.f / 256.f);
    const float dv = acc - mean; float s2 = wave_sum(dv * dv); if ((c & 63) == 0) red[4 + (c >> 6)] = s2; __syncthreads();
    const float var = (red[4] + red[5] + red[6] + red[7]) * (1.f / 256.f);
    const float y = dv * (1.0f / sqrtf(var + EPS)) * g_ln[layer * 256 + c] + b_ln[layer * 256 + c];
    const float yc = silu_f(y) * silu_f(bf2f(G[2048 + c]));
    AT[(size_t)hr * DM + 512 + c] = f2bf(yb); AT[(size_t)hr * DM + 768 + c] = f2bf(yc);
}

__global__ void __launch_bounds__(64) k_gemm_out(const bf16_t* __restrict__ AT, const bf16_t* __restrict__ WT, const float* xin, float* xout,
                                                 const float* __restrict__ modl, int hrow0, int rows_per_batch, int is_ctx) {
    const int lane = threadIdx.x, r32 = lane & 31, hi = lane >> 5;
    const int n0 = blockIdx.x * 128, m0 = blockIdx.y * 32;
    f32x16 acc[4];
#pragma unroll
    for (int i = 0; i < 4; ++i) acc[i] = f32x16{};
    const bf16_t* hp = AT + (size_t)(hrow0 + m0 + r32) * DM + hi * 8;
    const bf16_t* wp = WT + (size_t)(n0 + r32) * DM + hi * 8;
    for (int k = 0; k < DM; k += 16) {
        const bf16x8 bfr = *(const bf16x8*)(hp + k);
#pragma unroll
        for (int nb = 0; nb < 4; ++nb) { const bf16x8 afr = *(const bf16x8*)(wp + (size_t)nb * 32 * DM + k);
            acc[nb] = __builtin_amdgcn_mfma_f32_32x32x16_bf16(afr, bfr, acc[nb], 0, 0, 0); }
    }
    const int row = m0 + r32, mrow = is_ctx ? 8 : row / rows_per_batch;
    const float* gt = modl + (size_t)mrow * 3072 + 2048;
#pragma unroll
    for (int nb = 0; nb < 4; ++nb)
#pragma unroll
        for (int g = 0; g < 4; ++g) { const int n = n0 + 32 * nb + 8 * g + 4 * hi;
            const f32x4 xv = *(const f32x4*)(xin + (size_t)row * DM + n), gv = *(const f32x4*)(gt + n);
            f32x4 o; o.x = xv.x + gv.x * acc[nb][4 * g]; o.y = xv.y + gv.y * acc[nb][4 * g + 1]; o.z = xv.z + gv.z * acc[nb][4 * g + 2]; o.w = xv.w + gv.w * acc[nb][4 * g + 3];
            *(f32x4*)(xout + (size_t)row * DM + n) = o; }
}

__global__ void __launch_bounds__(256) k_final(float* __restrict__ x, const float* __restrict__ g, int nrows) {
    const int row = blockIdx.x * 4 + (threadIdx.x >> 6), lane = threadIdx.x & 63; if (row >= nrows) return;
    f32x4* xr = (f32x4*)(x + (size_t)row * DM) + lane;
    f32x4 v[4]; float ss = 0.f;
#pragma unroll
    for (int j = 0; j < 4; ++j) { v[j] = xr[64 * j]; ss += (v[j].x * v[j].x + v[j].y * v[j].y) + (v[j].z * v[j].z + v[j].w * v[j].w); }
    const float rstd = 1.0f / sqrtf(wave_sum(ss) * (1.f / DM) + EPS);
#pragma unroll
    for (int j = 0; j < 4; ++j) { const f32x4 gg = *(const f32x4*)(g + 4 * lane + 256 * j); f32x4 o = v[j] * rstd; o.x *= gg.x; o.y *= gg.y; o.z *= gg.z; o.w *= gg.w; xr[64 * j] = o; }
}

#include <hip/hip_cooperative_groups.h>
namespace cg = cooperative_groups;
namespace pg8 {
#define PG8_LAS __attribute__((address_space(3)))
typedef unsigned short bf16_t;
typedef short bf16x8 __attribute__((ext_vector_type(8)));
typedef float f32x4 __attribute__((ext_vector_type(4)));
typedef unsigned u32x4 __attribute__((ext_vector_type(4)));
constexpr int BM = 256, BK = 64, HALF = 128, HTB = HALF * BK * 2  , STAGE_BYTES = 8 * HTB, NXCD = 8, WGM = 8;

__host__ __device__ __forceinline__ int lds_byte(int r, int c) { const int st = (r >> 4) * 2 + (c >> 5), rr = r & 15, cc = c & 31, ob = rr * 64 + cc * 2; return st * 1024 + (ob ^ (((ob >> 9) & 1) << 5)); }
__host__ __device__ __forceinline__ void stage_rc(int b, int& R, int& C) { const int st = b / 1024, sb = b % 1024, swz = sb ^ (((sb >> 9) & 1) << 5); R = (st >> 1) * 16 + swz / 64; C = (st & 1) * 32 + (swz % 64) / 2; }
__host__ __device__ __forceinline__ int perm32(int rho) { const int n = rho >> 4, i = rho & 15; return 8 * (i >> 2) + 4 * n + (i & 3); }

struct Unit { int pm, pn; };
struct Gemm { const bf16_t* A; const bf16_t* Bt; int M, N, K; };

struct StaticOrder {
    int nM, nN, nwg, G, c;
    __host__ __device__ void init(int M, int N, int G_, int c_) { nM = M / BM; nN = N / BM; nwg = nM * nN; G = G_; c = c_; }
    __host__ __device__ bool next(int i, Unit& u) const {
        const long L = (long)i * G + c; if (L >= nwg) return false;
        int wgid = (int)L; { const int q = nwg / NXCD, r = nwg % NXCD, xcd = wgid % NXCD, off = wgid / NXCD; wgid = (xcd < r ? xcd * (q + 1) : r * (q + 1) + (xcd - r) * q) + off; }
        const int nig = WGM * nN, gid = wgid / nig, fm = gid * WGM, gsz = (nM - fm) < WGM ? (nM - fm) : WGM;
        u.pm = fm + ((wgid % nig) % gsz); u.pn = (wgid % nig) / gsz; return true;
    }
    __device__ __forceinline__ void a_ready(const Unit&) const {}
    __device__ __forceinline__ void done(const Unit&) const {}
};

__device__ __forceinline__ unsigned cvt_pk_bf16(float lo, float hi) { unsigned r; asm volatile("v_cvt_pk_bf16_f32 %0, %1, %2" : "=v"(r) : "v"(lo), "v"(hi)); return r; }
template <class Epi, class Sched, bool ALIGN_EPI = false, bool SP2 = false>
__device__ __forceinline__ void gemm_phase(PG8_LAS unsigned char* lds, const Gemm g, const Sched& S, const Epi& E) {
    const int tid = threadIdx.x, wid = __builtin_amdgcn_readfirstlane(tid >> 6), lane = tid & 63, wr = wid >> 2, wc = wid & 3, fr = lane & 15, fq = lane >> 4;
    const int K = g.K, nt = K / BK;
    unsigned voffA[2], voffB[2];
#pragma unroll
    for (int i = 0; i < 2; ++i) { int R, C; stage_rc(tid * 16 + i * 8192, R, C); const int Rb = Epi::PERM ? ((R & ~31) + perm32(R & 31)) : R;
        voffA[i] = (unsigned)(R * K + C) * 2u; voffB[i] = (unsigned)(Rb * K + C) * 2u; }
    const size_t kstep = (size_t)(BK * 2);
    const size_t hstep = (size_t)HALF * K * 2;
    const size_t tstep = 2 * hstep;
    const unsigned ldsw = (unsigned)wid * 1024u;
    const int aoff = lds_byte(wr * 64 + fr, fq * 8), boff = lds_byte(wc * 32 + fr, fq * 8);
#define PG8_SA(b, h) (((b) * 2 + (h)) * HTB)
#define PG8_SB(b, h) ((4 + (b) * 2 + (h)) * HTB)
#define PG8_STAGE(bufoff, gbase, voff) do { _Pragma("unroll") for (int _i = 0; _i < 2; ++_i) \
        __builtin_amdgcn_global_load_lds((const unsigned*)((const char*)(gbase) + (voff)[_i]), (PG8_LAS unsigned*)(lds + (bufoff) + ldsw + _i * 8192), 16, 0, 0); } while (0)
#define PG8_LDA(dst, b, h) do { _Pragma("unroll") for (int m = 0; m < 4; ++m) _Pragma("unroll") for (int k = 0; k < 2; ++k) dst[m][k] = *(const PG8_LAS bf16x8*)(lds + PG8_SA(b, h) + aoff + m * 2048 + k * 1024); } while (0)
#define PG8_LDB(dst, b, h) do { _Pragma("unroll") for (int n = 0; n < 2; ++n) _Pragma("unroll") for (int k = 0; k < 2; ++k) dst[n][k] = *(const PG8_LAS bf16x8*)(lds + PG8_SB(b, h) + boff + n * 2048 + k * 1024); } while (0)
#define PG8_MMA(ai, bj, At, Bt) do { __builtin_amdgcn_s_setprio(1); _Pragma("unroll") for (int m = 0; m < 4; ++m) _Pragma("unroll") for (int n = 0; n < 2; ++n) _Pragma("unroll") for (int k = 0; k < 2; ++k) \
        acc[ai][bj][m][n] = __builtin_amdgcn_mfma_f32_16x16x32_bf16(Bt[n][k], At[m][k], acc[ai][bj][m][n], 0, 0, 0); __builtin_amdgcn_s_setprio(0); } while (0)
#define PG8_WAIT_V(n) asm volatile("s_waitcnt vmcnt(" #n ")" ::: "memory")
#define PG8_WAIT_L(n) asm volatile("s_waitcnt lgkmcnt(" #n ")" ::: "memory")
#define PG8_BAR __builtin_amdgcn_s_barrier()
#define PG8_SCHED __builtin_amdgcn_sched_barrier(0)
    Unit cur, nxt; int ui = 0;
    if (!S.next(0, cur)) return;
    f32x4 acc[2][2][4][2];
#pragma unroll
    for (int a = 0; a < 2; ++a)
#pragma unroll
        for (int b = 0; b < 2; ++b)
#pragma unroll
            for (int m = 0; m < 4; ++m)
#pragma unroll
                for (int n = 0; n < 2; ++n) acc[a][b][m][n] = (f32x4){0.f, 0.f, 0.f, 0.f};
    bf16x8 At[4][2], B0[2][2], B1[2][2];
    const char* cA = (const char*)g.A + (size_t)cur.pm * tstep; const char* cB = (const char*)g.Bt + (size_t)cur.pn * tstep;
    S.a_ready(cur);
    if constexpr (SP2) {
        PG8_STAGE(PG8_SB(0, 0), cB, voffB); PG8_STAGE(PG8_SB(0, 1), cB + hstep, voffB); PG8_STAGE(PG8_SA(0, 0), cA, voffA); PG8_STAGE(PG8_SA(0, 1), cA + hstep, voffA);
        if (wr == 1) PG8_BAR;
        PG8_WAIT_V(2); PG8_BAR;
        PG8_STAGE(PG8_SB(1, 0), cB + kstep, voffB); PG8_STAGE(PG8_SA(1, 0), cA + kstep, voffA); PG8_STAGE(PG8_SB(1, 1), cB + hstep + kstep, voffB);
        PG8_WAIT_V(6); PG8_BAR;
    } else {
        PG8_STAGE(PG8_SB(0, 0), cB, voffB); PG8_STAGE(PG8_SA(0, 0), cA, voffA); PG8_STAGE(PG8_SB(0, 1), cB + hstep, voffB); PG8_STAGE(PG8_SA(0, 1), cA + hstep, voffA);
        if (wr == 1) PG8_BAR;
        PG8_WAIT_V(4); PG8_BAR;
        PG8_STAGE(PG8_SB(1, 0), cB + kstep, voffB); PG8_STAGE(PG8_SA(1, 0), cA + kstep, voffA); PG8_STAGE(PG8_SB(1, 1), cB + hstep + kstep, voffB);
        PG8_WAIT_V(6); PG8_BAR;
    }
    for (;;) {
        const bool has_next = S.next(ui + 1, nxt);
        const char* nA = has_next ? (const char*)g.A + (size_t)nxt.pm * tstep : cA; const char* nB = has_next ? (const char*)g.Bt + (size_t)nxt.pn * tstep : cB;
        for (int t = 0; t < nt; t += 2) {
            const bool last = (t == nt - 2);
            const char* a1 = cA + (size_t)(t + 1) * kstep;
            const char* a2 = last ? nA : cA + (size_t)(t + 2) * kstep; const char* b2 = last ? nB : cB + (size_t)(t + 2) * kstep;
            const char* a3 = a2 + kstep; const char* b3 = b2 + kstep;
            if (last && has_next) S.a_ready(nxt);
            if constexpr (SP2) {
            PG8_LDB(B0, 0, 0); PG8_LDB(B1, 0, 1); PG8_SCHED; PG8_LDA(At, 0, 0); PG8_STAGE(PG8_SA(1, 1), a1 + hstep, voffA);
            PG8_WAIT_V(8); PG8_WAIT_L(0); PG8_BAR; PG8_MMA(0, 0, At, B0); PG8_MMA(0, 1, At, B1); PG8_BAR; PG8_SCHED;
            PG8_LDA(At, 0, 1); PG8_STAGE(PG8_SB(0, 0), b2, voffB); PG8_STAGE(PG8_SB(0, 1), b2 + hstep, voffB); PG8_STAGE(PG8_SA(0, 0), a2, voffA);
            PG8_WAIT_V(8); PG8_WAIT_L(0); PG8_BAR; PG8_MMA(1, 0, At, B0); PG8_MMA(1, 1, At, B1); PG8_BAR; PG8_SCHED;
            PG8_LDB(B0, 1, 0); PG8_LDB(B1, 1, 1); PG8_SCHED; PG8_LDA(At, 1, 0); PG8_STAGE(PG8_SA(0, 1), a2 + hstep, voffA);
            PG8_WAIT_V(8); PG8_WAIT_L(0); PG8_BAR; PG8_MMA(0, 0, At, B0); PG8_MMA(0, 1, At, B1); PG8_BAR; PG8_SCHED;
            PG8_LDA(At, 1, 1); PG8_STAGE(PG8_SB(1, 0), b3, voffB); PG8_STAGE(PG8_SB(1, 1), b3 + hstep, voffB); PG8_STAGE(PG8_SA(1, 0), a3, voffA);
            PG8_WAIT_V(8); PG8_WAIT_L(0); PG8_BAR; PG8_MMA(1, 0, At, B0); PG8_MMA(1, 1, At, B1); PG8_BAR; PG8_SCHED;
            } else {
            PG8_LDB(B0, 0, 0); PG8_SCHED; PG8_LDA(At, 0, 0); PG8_STAGE(PG8_SA(1, 1), a1 + hstep, voffA);
            PG8_WAIT_L(8); PG8_BAR; PG8_WAIT_L(0); PG8_MMA(0, 0, At, B0); PG8_BAR; PG8_SCHED;
            PG8_LDB(B1, 0, 1); PG8_STAGE(PG8_SB(0, 0), b2, voffB);
            PG8_BAR; PG8_WAIT_L(0); PG8_MMA(0, 1, At, B1); PG8_BAR;
            PG8_LDA(At, 0, 1); PG8_STAGE(PG8_SA(0, 0), a2, voffA);
            PG8_BAR; PG8_WAIT_L(0); PG8_MMA(1, 0, At, B0); PG8_BAR; PG8_SCHED;
            PG8_STAGE(PG8_SB(0, 1), b2 + hstep, voffB);
            PG8_WAIT_V(6); PG8_BAR; PG8_MMA(1, 1, At, B1); PG8_BAR;
            PG8_LDB(B0, 1, 0); PG8_SCHED; PG8_LDA(At, 1, 0); PG8_STAGE(PG8_SA(0, 1), a2 + hstep, voffA);
            PG8_WAIT_L(8); PG8_BAR; PG8_WAIT_L(0); PG8_MMA(0, 0, At, B0); PG8_BAR; PG8_SCHED;
            PG8_LDB(B1, 1, 1); PG8_STAGE(PG8_SB(1, 0), b3, voffB);
            PG8_BAR; PG8_WAIT_L(0); PG8_MMA(0, 1, At, B1); PG8_BAR;
            PG8_LDA(At, 1, 1); PG8_STAGE(PG8_SA(1, 0), a3, voffA);
            PG8_BAR; PG8_WAIT_L(0); PG8_MMA(1, 0, At, B0); PG8_BAR; PG8_SCHED;
            PG8_STAGE(PG8_SB(1, 1), b3 + hstep, voffB);
            PG8_WAIT_V(6); PG8_BAR; PG8_MMA(1, 1, At, B1); PG8_BAR;
            }
        }
        if constexpr (ALIGN_EPI) { if (wr == 0) PG8_BAR; }
        if constexpr (!Epi::AFTER_DRAIN) { E(acc, cur, wr, wc, fr, fq); S.done(cur); }
        if (!has_next) break;
#pragma unroll
        for (int a = 0; a < 2; ++a)
#pragma unroll
            for (int b = 0; b < 2; ++b)
#pragma unroll
                for (int m = 0; m < 4; ++m)
#pragma unroll
                    for (int n = 0; n < 2; ++n) acc[a][b][m][n] = (f32x4){0.f, 0.f, 0.f, 0.f};
        cur = nxt; cA = nA; cB = nB; ++ui;
        if constexpr (ALIGN_EPI) { if (wr == 1) PG8_BAR; }
    }
    PG8_WAIT_V(0);
    if constexpr (!ALIGN_EPI) { if (wr == 0) PG8_BAR; }
    PG8_BAR;
    if constexpr (Epi::AFTER_DRAIN) { E.fused(acc, cur, wr, wc, fr, fq, lds, wid, lane); S.done(cur); }
#undef PG8_SA
#undef PG8_SB
#undef PG8_STAGE
#undef PG8_LDA
#undef PG8_LDB
#undef PG8_MMA
#undef PG8_WAIT_V
#undef PG8_WAIT_L
#undef PG8_BAR
#undef PG8_SCHED
}
}

struct EpiInProj {
    static constexpr bool PERM = true, AFTER_DRAIN = false;
    bf16_t *QB, *KB, *VB, *GB; const float2* rope;
    __device__ __forceinline__ void operator()(const pg8::f32x4 (&acc)[2][2][4][2], const pg8::Unit& u, int wr, int wc, int fr, int fq) const {
        const bool lat = u.pm < 128; const int b = lat ? (u.pm >> 4) : (u.pm - 128); const int t0 = lat ? (u.pm & 15) * 256 : 0;
        const int hr0 = u.pm * 256, kr0 = b * KEYS + (lat ? CTX : 0) + t0, pn = u.pn;
#pragma unroll
        for (int ai = 0; ai < 2; ++ai)
#pragma unroll
            for (int m = 0; m < 4; ++m) {
                const int rl = 128 * ai + 64 * wr + 16 * m + fr, t = t0 + rl;
#pragma unroll
                for (int bj = 0; bj < 2; ++bj) {
                    const int nl = 128 * bj + 32 * wc + 8 * fq;
                    pg8::f32x4 v0 = acc[ai][bj][m][0], v1 = acc[ai][bj][m][1];
                    bf16_t* dst;
                    if (pn < 4) {
                        if (lat) {
                            const int i0 = (nl & 63) >> 1; const int pos = (i0 < 16) ? (t >> 6) : (t & 63);
                            const pg8::f32x4* rp = (const pg8::f32x4*)(rope + pos * 16 + (i0 & 15)); const pg8::f32x4 c0 = rp[0], c1 = rp[1];
                            pg8::f32x4 o0, o1;
                            o0[0] = v0[0] * c0[0] - v0[1] * c0[1]; o0[1] = v0[0] * c0[1] + v0[1] * c0[0]; o0[2] = v0[2] * c0[2] - v0[3] * c0[3]; o0[3] = v0[2] * c0[3] + v0[3] * c0[2];
                            o1[0] = v1[0] * c1[0] - v1[1] * c1[1]; o1[1] = v1[0] * c1[1] + v1[1] * c1[0]; o1[2] = v1[2] * c1[2] - v1[3] * c1[3]; o1[3] = v1[2] * c1[3] + v1[3] * c1[2];
                            v0 = o0; v1 = o1;
                        }
                        if (pn < 2) { v0 = v0 * C2; v1 = v1 * C2; dst = QB + (size_t)(hr0 + rl) * 512 + pn * 256 + nl; }
                        else dst = KB + (size_t)(kr0 + rl) * 512 + (pn - 2) * 256 + nl;
                    } else if (pn < 6) dst = VB + (size_t)(kr0 + rl) * 512 + (pn - 4) * 256 + nl;
                    else dst = GB + (size_t)(hr0 + rl) * GW + (pn - 6) * 256 + nl;
                    pg8::u32x4 w; w.x = pg8::cvt_pk_bf16(v0[0], v0[1]); w.y = pg8::cvt_pk_bf16(v0[2], v0[3]); w.z = pg8::cvt_pk_bf16(v1[0], v1[1]); w.w = pg8::cvt_pk_bf16(v1[2], v1[3]);
                    *(pg8::u32x4*)dst = w;
                }
            }
    }
};
struct InSched {
    pg8::StaticOrder so; int G, c, nctx_cols, ctx_col0;
    __device__ void init(int G_, int c_, int nctx_cols_, int ctx_col0_) { so.init(NLAT, DIN, G_, c_); G = G_; c = c_; nctx_cols = nctx_cols_; ctx_col0 = ctx_col0_; }
    __device__ bool next(int i, pg8::Unit& u) const {
        const int L = i * G + c;
        if (L < 1920) return so.next(i, u);
        const int r = L - 1920; if (r >= 8 * nctx_cols) return false;
        u.pm = 128 + (r & 7); u.pn = ctx_col0 + (r >> 3); return true;
    }
    __device__ __forceinline__ void a_ready(const pg8::Unit&) const {}
    __device__ __forceinline__ void done(const pg8::Unit&) const {}
};

constexpr int LDS_BYTES = 147456;
struct MegaArgs { const float* in[20]; float* out; unsigned char* ws; int ph_lo, ph_hi; };

__global__ void __launch_bounds__(512, 2) mega(MegaArgs a) {
    extern __shared__ __attribute__((aligned(16))) unsigned char lds[];
    cg::grid_group grid = cg::this_grid();
    unsigned char* ws = a.ws;
    bf16_t* WIN = (bf16_t*)(ws + WS_WIN); bf16_t* H = (bf16_t*)(ws + WS_H);
    const int lo = a.ph_lo, hi = a.ph_hi;
#define IN(k) (lo <= (k) && (k) < hi)
#define BOTH(k) (IN(k) && IN((k) + 1))
    for (int l = 0; l < NL; ++l) {
        const int ph = 2 + 2 * l;
        if (IN(ph)) {
            pg8::Gemm g{H, WIN + (size_t)l * DIN * DM, MROWS, DIN, DM};
            InSched S; S.init((int)gridDim.x, (int)blockIdx.x, l == 0 ? 15 : 4, l == 0 ? 0 : 2);
            EpiInProj E{(bf16_t*)(ws + WS_QB), (bf16_t*)(ws + WS_KB), (bf16_t*)(ws + WS_VB), (bf16_t*)(ws + WS_GB), (const float2*)(ws + WS_ROPE)};
            pg8::gemm_phase<EpiInProj, InSched, true, true>((PG8_LAS unsigned char*)lds, g, S, E);
            if (BOTH(ph)) grid.sync();
        }
    }
#undef IN
#undef BOTH
}

static int launch_mega(MegaArgs& a, int lo, int hi, hipStream_t stream) {
    static int grid = 0;
    if (grid == 0) {
        int dev = 0, cus = 0, per_cu = 0;
        (void)hipGetDevice(&dev); (void)hipDeviceGetAttribute(&cus, hipDeviceAttributeMultiprocessorCount, dev);
        if (hipFuncSetAttribute((const void*)mega, hipFuncAttributeMaxDynamicSharedMemorySize, LDS_BYTES) != hipSuccess) { fprintf(stderr, "hipFuncSetAttribute failed\n"); grid = -1; return -1; }
        (void)hipOccupancyMaxActiveBlocksPerMultiprocessor(&per_cu, (const void*)mega, 512, LDS_BYTES);
        if (per_cu < 1) { fprintf(stderr, "mega: occupancy query says %d blocks/CU\n", per_cu); grid = -1; return -1; }
        grid = cus;
    }
    if (grid < 0) return -1;
    a.ph_lo = lo; a.ph_hi = hi;
    void* args[] = {&a};
    hipError_t e = hipLaunchCooperativeKernel((const void*)mega, dim3(grid), dim3(512), args, LDS_BYTES, stream);
    if (e != hipSuccess) { fprintf(stderr, "cooperative launch failed: %s (grid %d)\n", hipGetErrorString(e), grid); return -1; }
    return 0;
}

extern "C" void kernel_launch(void* const* d_in, const int* in_sizes, int n_in, void* d_out, int out_size, void* d_ws, size_t ws_size, hipStream_t stream) {
    if (n_in != 20 || in_sizes[0] != NLAT * DM || out_size != NLAT * DM || ws_size < WS_END) {
        fprintf(stderr, "kernel_launch: unexpected shapes (n_in %d in0 %d out %d ws %zu)\n", n_in, n_in > 0 ? in_sizes[0] : -1, out_size, ws_size); return; }
    const float* x = (const float*)d_in[0]; const float* c = (const float*)d_in[1]; const float* ctx = (const float*)d_in[2]; const float* cctx = (const float*)d_in[3];
    const float* w_ada = (const float*)d_in[4]; const float* b_ada = (const float*)d_in[5]; const float* g_norm = (const float*)d_in[6]; const float* w_in = (const float*)d_in[7];
    const float* lq1 = (const float*)d_in[8]; const float* lk1 = (const float*)d_in[9]; const float* lq2 = (const float*)d_in[10]; const float* lk2 = (const float*)d_in[11];
    const float* gsub = (const float*)d_in[12]; const float* w_short = (const float*)d_in[13]; const float* w_conf = (const float*)d_in[14]; const float* b_conf = (const float*)d_in[15];
    const float* g_ln = (const float*)d_in[16]; const float* b_ln = (const float*)d_in[17]; const float* w_out = (const float*)d_in[18]; const float* g_final = (const float*)d_in[19];
    unsigned char* ws = (unsigned char*)d_ws; float* out = (float*)d_out;
    float* MOD = (float*)(ws + WS_MOD); float2* ROPE = (float2*)(ws + WS_ROPE);
    bf16_t* WIN = (bf16_t*)(ws + WS_WIN); bf16_t* WOUT = (bf16_t*)(ws + WS_WOUT); bf16_t* H = (bf16_t*)(ws + WS_H);
    bf16_t* QB = (bf16_t*)(ws + WS_QB); bf16_t* KB = (bf16_t*)(ws + WS_KB); bf16_t* VB = (bf16_t*)(ws + WS_VB); bf16_t* GB = (bf16_t*)(ws + WS_GB);
    float* CTX1 = (float*)(ws + WS_CTX1); bf16_t* AT = (bf16_t*)(ws + WS_AT);
    MegaArgs ma{}; for (int i = 0; i < 20; ++i) ma.in[i] = (const float*)d_in[i]; ma.out = out; ma.ws = ws;
    for (int l = 0; l < NL; ++l) {
        k_transpose<<<dim3(DIN / 32, DM / 32), 256, 0, stream>>>(w_in + (size_t)l * DM * DIN, WIN + (size_t)l * DIN * DM, DM, DIN);
        k_transpose<<<dim3(DM / 32, DM / 32), 256, 0, stream>>>(w_out + (size_t)l * DM * DM, WOUT + (size_t)l * DM * DM, DM, DM);
    }
    k_mod<<<dim3(3072 / 64, NL), 256, 0, stream>>>(c, cctx, w_ada, b_ada, MOD);
    k_rope<<<4, 256, 0, stream>>>(ROPE);
    for (int l = 0; l < NL; ++l) {
        const float* xin = l == 0 ? x : out; const float* cin = l == 0 ? ctx : CTX1; const float* modl = MOD + (size_t)l * 9 * 3072;
        k_normmod<<<NLAT / 4, 256, 0, stream>>>(xin, NLAT, SEQ, 0, g_norm + l * DM, modl, H, 0);
        k_normmod<<<NCTX / 4, 256, 0, stream>>>(cin, NCTX, CTX, 1, g_norm + l * DM, modl, H, NLAT);
        if (launch_mega(ma, 2 + 2 * l, 3 + 2 * l, stream)) return;
        k_attn_naive<<<dim3(SEQ / 64, 4, NB), 128, 0, stream>>>(QB, KB, VB, GB, AT, lq1, lk1, lq2, lk2, gsub, l, 0);
        k_conv<<<NLAT, 256, 0, stream>>>(GB, AT, w_short, w_conf, b_conf, g_ln, b_ln, l, 0);
        if (l == 0) {
            k_attn_naive<<<dim3(CTX / 64, 4, NB), 128, 0, stream>>>(QB, KB, VB, GB, AT, lq1, lk1, lq2, lk2, gsub, l, 1);
            k_conv<<<NCTX, 256, 0, stream>>>(GB, AT, w_short, w_conf, b_conf, g_ln, b_ln, l, NLAT);
            k_gemm_out<<<dim3(DM / 128, NCTX / 32), 64, 0, stream>>>(AT, WOUT + (size_t)l * DM * DM, ctx, CTX1, modl, NLAT, CTX, 1);
        }
        k_gemm_out<<<dim3(DM / 128, NLAT / 32), 64, 0, stream>>>(AT, WOUT + (size_t)l * DM * DM, xin, out, modl, 0, SEQ, 0);
    }
    k_final<<<NLAT / 4, 256, 0, stream>>>(out, g_final, NLAT);
}
```

```cpp
#include <hip/hip_runtime.h>
#include <stdint.h>
#include <stdio.h>

typedef unsigned short bf16_t;
typedef short bf16x8 __attribute__((ext_vector_type(8)));
typedef float f32x16 __attribute__((ext_vector_type(16)));
typedef float f32x4 __attribute__((ext_vector_type(4)));

constexpr int NB = 8, SEQ = 4096, DM = 1024, NL = 2, CTX = 256, DIN = 3840;
constexpr int NLAT = NB * SEQ;
constexpr int NCTX = NB * CTX;
constexpr int MROWS = NLAT + NCTX;
constexpr int KEYS = CTX + SEQ;
constexpr int GW = 2304;
constexpr float EPS = 1e-6f;
constexpr float C2 = 0.125f * 1.4426950408889634f;

constexpr size_t MiB = 1u << 20;
constexpr size_t WS_CTL = 0;
constexpr size_t WS_MOD = 1 * MiB;
constexpr size_t WS_ROPE = WS_MOD + 512 * 1024;
constexpr size_t WS_WIN = 2 * MiB;
constexpr size_t WS_WOUT = 18 * MiB;
constexpr size_t WS_H = 22 * MiB;
constexpr size_t WS_QB = 94 * MiB;
constexpr size_t WS_KB = 130 * MiB;
constexpr size_t WS_VB = 164 * MiB;
constexpr size_t WS_GB = 198 * MiB;
constexpr size_t WS_CTX1 = 360 * MiB;
constexpr size_t WS_AT = 368 * MiB;
constexpr size_t WS_END = 440 * MiB;

__device__ __forceinline__ float bf2f(bf16_t v) { return __uint_as_float((unsigned)v << 16); }
__device__ __forceinline__ bf16_t f2bf(float f) { unsigned u = __float_as_uint(f); return (bf16_t)((u + 0x7fffu + ((u >> 16) & 1u)) >> 16); }
__device__ __forceinline__ float silu_f(float x) { return x / (1.f + __expf(-x)); }
__device__ __forceinline__ float sigmoid_f(float x) { return 1.f / (1.f + __expf(-x)); }
__device__ __forceinline__ float wave_sum(float v) {
#pragma unroll
    for (int o = 1; o < 64; o <<= 1) v += __shfl_xor(v, o);
    return v;
}

__global__ void __launch_bounds__(256) k_transpose(const float* __restrict__ W, bf16_t* __restrict__ WT, int K, int N) {
    __shared__ float t[32][33];
    const int n0 = blockIdx.x * 32, k0 = blockIdx.y * 32, tx = threadIdx.x & 31, ty = threadIdx.x >> 5;
    for (int i = ty; i < 32; i += 8) t[i][tx] = W[(size_t)(k0 + i) * N + n0 + tx];
    __syncthreads();
    for (int i = ty; i < 32; i += 8) WT[(size_t)(n0 + i) * K + k0 + tx] = f2bf(t[tx][i]);
}

__global__ void __launch_bounds__(256) k_mod(const float* __restrict__ c, const float* __restrict__ cctx, const float* __restrict__ w_ada,
                                             const float* __restrict__ b_ada, float* __restrict__ MOD) {
    __shared__ float s[9][1024];
    __shared__ float red[4][9][64];
    const int l = blockIdx.y, n = blockIdx.x * 64 + (threadIdx.x & 63), kq = threadIdx.x >> 6;
    for (int i = threadIdx.x; i < 9 * 1024; i += 256) { const int r = i >> 10, k = i & 1023; const float v = r < 8 ? c[r * 1024 + k] : cctx[k]; s[r][k] = silu_f(v); }
    __syncthreads();
    float acc[9];
#pragma unroll
    for (int r = 0; r < 9; ++r) acc[r] = 0.f;
    const float* w = w_ada + (size_t)l * 1024 * 3072 + n;
    for (int k = kq * 256; k < kq * 256 + 256; ++k) { const float wv = w[(size_t)k * 3072];
#pragma unroll
        for (int r = 0; r < 9; ++r) acc[r] += s[r][k] * wv; }
#pragma unroll
    for (int r = 0; r < 9; ++r) red[kq][r][threadIdx.x & 63] = acc[r];
    __syncthreads();
    if (kq == 0) {
#pragma unroll
        for (int r = 0; r < 9; ++r) { const int j = threadIdx.x & 63; const float v = (red[0][r][j] + red[1][r][j]) + (red[2][r][j] + red[3][r][j]);
            MOD[((size_t)l * 9 + r) * 3072 + n] = v + b_ada[l * 3072 + n]; }
    }
}

__global__ void k_rope(float2* __restrict__ tab) {
    const int i = threadIdx.x + blockIdx.x * blockDim.x; if (i >= 1024) return;
    const int pos = i >> 4, f = i & 15;
    double inv = 1.0; for (int j = 0; j < f; ++j) inv *= 0.5623413251903491;
    const double ang = (double)pos * inv;
    const double hp = 1.5707963267948966;
    const double kq = __builtin_floor(ang / hp + 0.5); const double r = ang - kq * hp - kq * 6.123233995736766e-17;
    const double r2 = r * r;
    double sn = r * (1.0 + r2 * (-1.0 / 6 + r2 * (1.0 / 120 + r2 * (-1.0 / 5040 + r2 * (1.0 / 362880 + r2 * (-1.0 / 39916800 + r2 * (1.0 / 6227020800.0 + r2 * (-1.0 / 1307674368000.0))))))));
    double cs = 1.0 + r2 * (-0.5 + r2 * (1.0 / 24 + r2 * (-1.0 / 720 + r2 * (1.0 / 40320 + r2 * (-1.0 / 3628800 + r2 * (1.0 / 479001600.0 + r2 * (-1.0 / 87178291200.0 + r2 * (1.0 / 20922789888000.0))))))));
    const int q = ((int)kq) & 3; double co, si;
    if (q == 0) { co = cs; si = sn; } else if (q == 1) { co = -sn; si = cs; } else if (q == 2) { co = -cs; si = -sn; } else { co = sn; si = -cs; }
    tab[i] = make_float2((float)co, (float)si);
}

__global__ void __launch_bounds__(256) k_normmod(const float* __restrict__ src, int nrows, int rows_per_batch, int is_ctx,
                                                 const float* __restrict__ g, const float* __restrict__ modl, bf16_t* __restrict__ H, int hrow0) {
    const int row = blockIdx.x * 4 + (threadIdx.x >> 6), lane = threadIdx.x & 63; if (row >= nrows) return;
    const int mrow = is_ctx ? 8 : row / rows_per_batch;
    const f32x4* xr = (const f32x4*)(src + (size_t)row * DM) + lane;
    f32x4 v[4]; float ss = 0.f;
#pragma unroll
    for (int j = 0; j < 4; ++j) { v[j] = xr[64 * j]; ss += (v[j].x * v[j].x + v[j].y * v[j].y) + (v[j].z * v[j].z + v[j].w * v[j].w); }
    const float rstd = 1.0f / sqrtf(wave_sum(ss) * (1.f / DM) + EPS);
    const float* sh = modl + (size_t)mrow * 3072; const float* sc = sh + 1024;
    bf16_t* o = H + (size_t)(hrow0 + row) * DM;
#pragma unroll
    for (int j = 0; j < 4; ++j) { const int k = 4 * lane + 256 * j;
        const f32x4 gg = *(const f32x4*)(g + k), s1 = *(const f32x4*)(sc + k), s0 = *(const f32x4*)(sh + k);
        ushort4 w; w.x = f2bf(v[j].x * rstd * gg.x * (1.f + s1.x) + s0.x); w.y = f2bf(v[j].y * rstd * gg.y * (1.f + s1.y) + s0.y);
        w.z = f2bf(v[j].z * rstd * gg.z * (1.f + s1.z) + s0.z); w.w = f2bf(v[j].w * rstd * gg.w * (1.f + s1.w) + s0.w);
        *(ushort4*)(o + k) = w; }
}

struct InProjOut { bf16_t* QB; bf16_t* KB; bf16_t* VB; bf16_t* GB; const float2* rope; };
__device__ __forceinline__ void inproj_store4(const InProjOut& P, int hr, int n, float v0, float v1, float v2, float v3) {
    const bool lat = hr < NLAT; int b, t;
    if (lat) { b = hr >> 12; t = hr & 4095; } else { const int c = hr - NLAT; b = c >> 8; t = c & 255; }
    bf16_t* dst;
    if (n < 1024) {
        if (lat) {
            const int i0 = (n & 63) >> 1;
            { const int i = i0; const int pos = (i < 16) ? (t >> 6) : (t & 63); const float2 cs = P.rope[pos * 16 + (i & 15)];
              const float a = v0, bq = v1; v0 = a * cs.x - bq * cs.y; v1 = a * cs.y + bq * cs.x; }
            { const int i = i0 + 1; const int pos = (i < 16) ? (t >> 6) : (t & 63); const float2 cs = P.rope[pos * 16 + (i & 15)];
              const float a = v2, bq = v3; v2 = a * cs.x - bq * cs.y; v3 = a * cs.y + bq * cs.x; }
        }
        if (n < 512) { v0 *= C2; v1 *= C2; v2 *= C2; v3 *= C2; dst = P.QB + (size_t)hr * 512 + n; }
        else { const int kr = b * KEYS + (lat ? CTX + t : t); dst = P.KB + (size_t)kr * 512 + (n - 512); }
    } else if (n < 1536) { const int kr = b * KEYS + (lat ? CTX + t : t); dst = P.VB + (size_t)kr * 512 + (n - 1024); }
    else dst = P.GB + (size_t)hr * GW + (n - 1536);
    ushort4 w; w.x = f2bf(v0); w.y = f2bf(v1); w.z = f2bf(v2); w.w = f2bf(v3);
    *(ushort4*)dst = w;
}

__global__ void __launch_bounds__(64) k_gemm_in(const bf16_t* __restrict__ H, const bf16_t* __restrict__ WT, InProjOut P, int mrow0) {
    const int lane = threadIdx.x, r32 = lane & 31, hi = lane >> 5;
    const int n0 = blockIdx.x * 128, m0 = mrow0 + blockIdx.y * 32;
    f32x16 acc[4];
#pragma unroll
    for (int i = 0; i < 4; ++i) acc[i] = f32x16{};
    const bf16_t* hp = H + (size_t)(m0 + r32) * DM + hi * 8;
    const bf16_t* wp = WT + (size_t)(n0 + r32) * DM + hi * 8;
    for (int k = 0; k < DM; k += 16) {
        const bf16x8 bfr = *(const bf16x8*)(hp + k);
#pragma unroll
        for (int nb = 0; nb < 4; ++nb) { const bf16x8 afr = *(const bf16x8*)(wp + (size_t)nb * 32 * DM + k);
            acc[nb] = __builtin_amdgcn_mfma_f32_32x32x16_bf16(afr, bfr, acc[nb], 0, 0, 0); }
    }
#pragma unroll
    for (int nb = 0; nb < 4; ++nb)
#pragma unroll
        for (int g = 0; g < 4; ++g) inproj_store4(P, m0 + r32, n0 + 32 * nb + 8 * g + 4 * hi, acc[nb][4 * g], acc[nb][4 * g + 1], acc[nb][4 * g + 2], acc[nb][4 * g + 3]);
}

__global__ void __launch_bounds__(128) k_attn_naive(const bf16_t* __restrict__ QB, const bf16_t* __restrict__ KB, const bf16_t* __restrict__ VB,
                                                    const bf16_t* __restrict__ GB, bf16_t* __restrict__ AT, const float* __restrict__ lq1, const float* __restrict__ lk1,
                                                    const float* __restrict__ lq2, const float* __restrict__ lk2, const float* __restrict__ gsub, int layer, int is_ctx) {
    __shared__ float sh[64][129];
    const int q = threadIdx.x & 63, m = __builtin_amdgcn_readfirstlane(threadIdx.x >> 6);
    const int h = blockIdx.y, b = blockIdx.z;
    const int hr = is_ctx ? NLAT + b * CTX + blockIdx.x * 64 + q : b * SEQ + blockIdx.x * 64 + q;
    const int nkeys = is_ctx ? CTX : KEYS;
    float qv[64];
    { const bf16_t* qp = QB + (size_t)hr * 512 + h * 128 + m * 64;
#pragma unroll
      for (int d = 0; d < 64; d += 8) { const uint4 u = *(const uint4*)(qp + d); const unsigned w[4] = {u.x, u.y, u.z, u.w};
#pragma unroll
          for (int e = 0; e < 4; ++e) { qv[d + 2 * e] = __uint_as_float(w[e] << 16); qv[d + 2 * e + 1] = __uint_as_float(w[e] & 0xffff0000u); } } }
    const bf16_t* kbase = KB + (size_t)b * KEYS * 512 + h * 128 + m * 64;
    const bf16_t* vbase = VB + (size_t)b * KEYS * 512 + h * 128;
    float mx = -3.0e38f;
    for (int j = 0; j < nkeys; ++j) {
        const uint4* kp = (const uint4*)(kbase + (size_t)j * 512); float s = 0.f;
#pragma unroll
        for (int c = 0; c < 8; ++c) { const uint4 u = kp[c]; const unsigned w[4] = {u.x, u.y, u.z, u.w};
#pragma unroll
            for (int e = 0; e < 4; ++e) { s += qv[8 * c + 2 * e] * __uint_as_float(w[e] << 16); s += qv[8 * c + 2 * e + 1] * __uint_as_float(w[e] & 0xffff0000u); } }
        mx = fmaxf(mx, s);
    }
    float o[128], l = 0.f;
#pragma unroll
    for (int d = 0; d < 128; ++d) o[d] = 0.f;
    for (int j = 0; j < nkeys; ++j) {
        const uint4* kp = (const uint4*)(kbase + (size_t)j * 512); float s = 0.f;
#pragma unroll
        for (int c = 0; c < 8; ++c) { const uint4 u = kp[c]; const unsigned w[4] = {u.x, u.y, u.z, u.w};
#pragma unroll
            for (int e = 0; e < 4; ++e) { s += qv[8 * c + 2 * e] * __uint_as_float(w[e] << 16); s += qv[8 * c + 2 * e + 1] * __uint_as_float(w[e] & 0xffff0000u); } }
        const float p = __builtin_amdgcn_exp2f(s - mx); l += p;
        const uint4* vp = (const uint4*)(vbase + (size_t)j * 512);
#pragma unroll
        for (int c = 0; c < 16; ++c) { const uint4 u = vp[c]; const unsigned w[4] = {u.x, u.y, u.z, u.w};
#pragma unroll
            for (int e = 0; e < 4; ++e) { o[8 * c + 2 * e] += p * __uint_as_float(w[e] << 16); o[8 * c + 2 * e + 1] += p * __uint_as_float(w[e] & 0xffff0000u); } }
    }
    const float rl = 1.f / l;
    if (m == 1) {
#pragma unroll
        for (int d = 0; d < 128; ++d) sh[q][d] = o[d] * rl;
    }
    __syncthreads();
    if (m == 0) {
        float s1 = 0.f, s2 = 0.f;
        for (int d = 0; d < 64; ++d) { s1 += lq1[layer * 64 + d] * lk1[layer * 64 + d]; s2 += lq2[layer * 64 + d] * lk2[layer * 64 + d]; }
        const float lam_init = 0.8f - 0.6f * expf(-0.3f * (float)layer);
        const float lam = expf(s1) - expf(s2) + lam_init;
        float ss = 0.f;
#pragma unroll
        for (int d = 0; d < 128; ++d) { o[d] = o[d] * rl - lam * sh[q][d]; ss += o[d] * o[d]; }
        const float r = 1.0f / sqrtf(ss * (1.f / 128.f) + EPS) * (1.f - lam_init);
        const bf16_t* ga = GB + (size_t)hr * GW + h * 128;
        bf16_t* at = AT + (size_t)hr * DM + h * 128;
#pragma unroll
        for (int d = 0; d < 128; ++d) at[d] = f2bf(o[d] * r * gsub[layer * 128 + d] * silu_f(bf2f(ga[d])));
    }
}

__global__ void __launch_bounds__(256) k_conv(const bf16_t* __restrict__ GB, bf16_t* __restrict__ AT, const float* __restrict__ w_short, const float* __restrict__ w_conf,
                                              const float* __restrict__ b_conf, const float* __restrict__ g_ln, const float* __restrict__ b_ln, int layer, int hr0) {
    __shared__ float red[8];
    const int hr = hr0 + blockIdx.x, c = threadIdx.x;
    int t, len; if (hr < NLAT) { t = hr & 4095; len = SEQ; } else { t = (hr - NLAT) & 255; len = CTX; }
    const bf16_t* G = GB + (size_t)hr * GW;
    float accb = 0.f;
#pragma unroll
    for (int j = 0; j < 3; ++j) { const int tt = t + j - 1; if (tt >= 0 && tt < len) { const bf16_t* Gt = G + (ptrdiff_t)(j - 1) * GW; accb += w_short[(layer * 3 + j) * 256 + c] * (bf2f(Gt[768 + c]) * bf2f(Gt[1024 + c])); } }
    const float yb = bf2f(G[512 + c]) * accb * silu_f(bf2f(G[1280 + c]));
    float acc = b_conf[layer * 256 + c];
    for (int j = 0; j < 31; ++j) { const int tt = t + j - 15; if (tt >= 0 && tt < len) { const bf16_t* Gt = G + (ptrdiff_t)(j - 15) * GW;
        acc += w_conf[(layer * 31 + j) * 256 + c] * (bf2f(Gt[1536 + c]) * sigmoid_f(bf2f(Gt[1792 + c]))); } }
    float s = wave_sum(acc); if ((c & 63) == 0) red[c >> 6] = s; __syncthreads();
    const float mean = (red[0] + red[1] + red[2] + red[3]) * (1.f / 256.f);
    const float dv = acc - mean; float s2 = wave_sum(dv * dv); if ((c & 63) == 0) red[4 + (c >> 6)] = s2; __syncthreads();
    const float var = (red[4] + red[5] + red[6] + red[7]) * (1.f / 256.f);
    const float y = dv * (1.0f / sqrtf(var + EPS)) * g_ln[layer * 256 + c] + b_ln[layer * 256 + c];
    const float yc = silu_f(y) * silu_f(bf2f(G[2048 + c]));
    AT[(size_t)hr * DM + 512 + c] = f2bf(yb); AT[(size_t)hr * DM + 768 + c] = f2bf(yc);
}

__global__ void __launch_bounds__(64) k_gemm_out(const bf16_t* __restrict__ AT, const bf16_t* __restrict__ WT, const float* xin, float* xout,
                                                 const float* __restrict__ modl, int hrow0, int rows_per_batch, int is_ctx) {
    const int lane = threadIdx.x, r32 = lane & 31, hi = lane >> 5;
    const int n0 = blockIdx.x * 128, m0 = blockIdx.y * 32;
    f32x16 acc[4];
#pragma unroll
    for (int i = 0; i < 4; ++i) acc[i] = f32x16{};
    const bf16_t* hp = AT + (size_t)(hrow0 + m0 + r32) * DM + hi * 8;
    const bf16_t* wp = WT + (size_t)(n0 + r32) * DM + hi * 8;
    for (int k = 0; k < DM; k += 16) {
        const bf16x8 bfr = *(const bf16x8*)(hp + k);
#pragma unroll
        for (int nb = 0; nb < 4; ++nb) { const bf16x8 afr = *(const bf16x8*)(wp + (size_t)nb * 32 * DM + k);
            acc[nb] = __builtin_amdgcn_mfma_f32_32x32x16_bf16(afr, bfr, acc[nb], 0, 0, 0); }
    }
    const int row = m0 + r32, mrow = is_ctx ? 8 : row / rows_per_batch;
    const float* gt = modl + (size_t)mrow * 3072 + 2048;
#pragma unroll
    for (int nb = 0; nb < 4; ++nb)
#pragma unroll
        for (int g = 0; g < 4; ++g) { const int n = n0 + 32 * nb + 8 * g + 4 * hi;
            const f32x4 xv = *(const f32x4*)(xin + (size_t)row * DM + n), gv = *(const f32x4*)(gt + n);
            f32x4 o; o.x = xv.x + gv.x * acc[nb][4 * g]; o.y = xv.y + gv.y * acc[nb][4 * g + 1]; o.z = xv.z + gv.z * acc[nb][4 * g + 2]; o.w = xv.w + gv.w * acc[nb][4 * g + 3];
            *(f32x4*)(xout + (size_t)row * DM + n) = o; }
}

__global__ void __launch_bounds__(256) k_final(float* __restrict__ x, const float* __restrict__ g, int nrows) {
    const int row = blockIdx.x * 4 + (threadIdx.x >> 6), lane = threadIdx.x & 63; if (row >= nrows) return;
    f32x4* xr = (f32x4*)(x + (size_t)row * DM) + lane;
    f32x4 v[4]; float ss = 0.f;
#pragma unroll
    for (int j = 0; j < 4; ++j) { v[j] = xr[64 * j]; ss += (v[j].x * v[j].x + v[j].y * v[j].y) + (v[j].z * v[j].z + v[j].w * v[j].w); }
    const float rstd = 1.0f / sqrtf(wave_sum(ss) * (1.f / DM) + EPS);
#pragma unroll
    for (int j = 0; j < 4; ++j) { const f32x4 gg = *(const f32x4*)(g + 4 * lane + 256 * j); f32x4 o = v[j] * rstd; o.x *= gg.x; o.y *= gg.y; o.z *= gg.z; o.w *= gg.w; xr[64 * j] = o; }
}

#include <hip/hip_cooperative_groups.h>
namespace cg = cooperative_groups;
namespace pg8 {
#define PG8_LAS __attribute__((address_space(3)))
typedef unsigned short bf16_t;
typedef short bf16x8 __attribute__((ext_vector_type(8)));
typedef float f32x4 __attribute__((ext_vector_type(4)));
typedef unsigned u32x4 __attribute__((ext_vector_type(4)));
constexpr int BM = 256, BK = 64, HALF = 128, HTB = HALF * BK * 2  , STAGE_BYTES = 8 * HTB, NXCD = 8, WGM = 8;

__host__ __device__ __forceinline__ int lds_byte(int r, int c) { const int st = (r >> 4) * 2 + (c >> 5), rr = r & 15, cc = c & 31, ob = rr * 64 + cc * 2; return st * 1024 + (ob ^ (((ob >> 9) & 1) << 5)); }
__host__ __device__ __forceinline__ void stage_rc(int b, int& R, int& C) { const int st = b / 1024, sb = b % 1024, swz = sb ^ (((sb >> 9) & 1) << 5); R = (st >> 1) * 16 + swz / 64; C = (st & 1) * 32 + (swz % 64) / 2; }
__host__ __device__ __forceinline__ int perm32(int rho) { const int n = rho >> 4, i = rho & 15; return 8 * (i >> 2) + 4 * n + (i & 3); }

struct Unit { int pm, pn; };
struct Gemm { const bf16_t* A; const bf16_t* Bt; int M, N, K; };

struct StaticOrder {
    int nM, nN, nwg, G, c;
    __host__ __device__ void init(int M, int N, int G_, int c_) { nM = M / BM; nN = N / BM; nwg = nM * nN; G = G_; c = c_; }
    __host__ __device__ bool next(int i, Unit& u) const {
        const long L = (long)i * G + c; if (L >= nwg) return false;
        int wgid = (int)L; { const int q = nwg / NXCD, r = nwg % NXCD, xcd = wgid % NXCD, off = wgid / NXCD; wgid = (xcd < r ? xcd * (q + 1) : r * (q + 1) + (xcd - r) * q) + off; }
        const int nig = WGM * nN, gid = wgid / nig, fm = gid * WGM, gsz = (nM - fm) < WGM ? (nM - fm) : WGM;
        u.pm = fm + ((wgid % nig) % gsz); u.pn = (wgid % nig) / gsz; return true;
    }
    __device__ __forceinline__ void a_ready(const Unit&) const {}
    __device__ __forceinline__ void done(const Unit&) const {}
};

__device__ __forceinline__ unsigned cvt_pk_bf16(float lo, float hi) { unsigned r; asm volatile("v_cvt_pk_bf16_f32 %0, %1, %2" : "=v"(r) : "v"(lo), "v"(hi)); return r; }
template <class Epi, class Sched, bool ALIGN_EPI = false, bool SP2 = false>
__device__ __forceinline__ void gemm_phase(PG8_LAS unsigned char* lds, const Gemm g, const Sched& S, const Epi& E) {
    int tid_ = threadIdx.x; asm volatile("" : "+v"(tid_));
    const int tid = tid_, wid = __builtin_amdgcn_readfirstlane(tid >> 6), lane = tid & 63, wr = wid >> 2, wc = wid & 3, fr = lane & 15, fq = lane >> 4;
    const int K = g.K, nt = K / BK;
    unsigned voffA[2], voffB[2];
#pragma unroll
    for (int i = 0; i < 2; ++i) { int R, C; stage_rc(tid * 16 + i * 8192, R, C); const int Rb = Epi::PERM ? ((R & ~31) + perm32(R & 31)) : R;
        voffA[i] = (unsigned)(R * K + C) * 2u; voffB[i] = (unsigned)(Rb * K + C) * 2u; }
    const size_t kstep = (size_t)(BK * 2);
    const size_t hstep = (size_t)HALF * K * 2;
    const size_t tstep = 2 * hstep;
    const unsigned ldsw = (unsigned)wid * 1024u;
    const int aoff = lds_byte(wr * 64 + fr, fq * 8), boff = lds_byte(wc * 32 + fr, fq * 8);
#define PG8_SA(b, h) (((b) * 2 + (h)) * HTB)
#define PG8_SB(b, h) ((4 + (b) * 2 + (h)) * HTB)
#define PG8_STAGE(bufoff, gbase, voff) do { _Pragma("unroll") for (int _i = 0; _i < 2; ++_i) \
        __builtin_amdgcn_global_load_lds((const unsigned*)((const char*)(gbase) + (voff)[_i]), (PG8_LAS unsigned*)(lds + (bufoff) + ldsw + _i * 8192), 16, 0, 0); } while (0)
#define PG8_LDA(dst, b, h) do { _Pragma("unroll") for (int m = 0; m < 4; ++m) _Pragma("unroll") for (int k = 0; k < 2; ++k) dst[m][k] = *(const PG8_LAS bf16x8*)(lds + PG8_SA(b, h) + aoff + m * 2048 + k * 1024); } while (0)
#define PG8_LDB(dst, b, h) do { _Pragma("unroll") for (int n = 0; n < 2; ++n) _Pragma("unroll") for (int k = 0; k < 2; ++k) dst[n][k] = *(const PG8_LAS bf16x8*)(lds + PG8_SB(b, h) + boff + n * 2048 + k * 1024); } while (0)
#define PG8_MMA(ai, bj, At, Bt) do { __builtin_amdgcn_s_setprio(1); _Pragma("unroll") for (int m = 0; m < 4; ++m) _Pragma("unroll") for (int n = 0; n < 2; ++n) _Pragma("unroll") for (int k = 0; k < 2; ++k) \
        acc[ai][bj][m][n] = __builtin_amdgcn_mfma_f32_16x16x32_bf16(Bt[n][k], At[m][k], acc[ai][bj][m][n], 0, 0, 0); __builtin_amdgcn_s_setprio(0); } while (0)
#define PG8_WAIT_V(n) asm volatile("s_waitcnt vmcnt(" #n ")" ::: "memory")
#define PG8_WAIT_L(n) asm volatile("s_waitcnt lgkmcnt(" #n ")" ::: "memory")
#define PG8_BAR __builtin_amdgcn_s_barrier()
#define PG8_SCHED __builtin_amdgcn_sched_barrier(0)
    Unit cur, nxt; int ui = 0;
    if (!S.next(0, cur)) return;
    f32x4 acc[2][2][4][2];
#pragma unroll
    for (int a = 0; a < 2; ++a)
#pragma unroll
        for (int b = 0; b < 2; ++b)
#pragma unroll
            for (int m = 0; m < 4; ++m)
#pragma unroll
                for (int n = 0; n < 2; ++n) acc[a][b][m][n] = (f32x4){0.f, 0.f, 0.f, 0.f};
    bf16x8 At[4][2], B0[2][2], B1[2][2];
    const char* cA = (const char*)g.A + (size_t)cur.pm * tstep; const char* cB = (const char*)g.Bt + (size_t)cur.pn * tstep;
    S.a_ready(cur);
    if constexpr (SP2) {
        PG8_STAGE(PG8_SB(0, 0), cB, voffB); PG8_STAGE(PG8_SB(0, 1), cB + hstep, voffB); PG8_STAGE(PG8_SA(0, 0), cA, voffA); PG8_STAGE(PG8_SA(0, 1), cA + hstep, voffA);
        if (wr == 1) PG8_BAR;
        PG8_WAIT_V(2); PG8_BAR;
        PG8_STAGE(PG8_SB(1, 0), cB + kstep, voffB); PG8_STAGE(PG8_SA(1, 0), cA + kstep, voffA); PG8_STAGE(PG8_SB(1, 1), cB + hstep + kstep, voffB);
        PG8_WAIT_V(6); PG8_BAR;
    } else {
        PG8_STAGE(PG8_SB(0, 0), cB, voffB); PG8_STAGE(PG8_SA(0, 0), cA, voffA); PG8_STAGE(PG8_SB(0, 1), cB + hstep, voffB); PG8_STAGE(PG8_SA(0, 1), cA + hstep, voffA);
        if (wr == 1) PG8_BAR;
        PG8_WAIT_V(4); PG8_BAR;
        PG8_STAGE(PG8_SB(1, 0), cB + kstep, voffB); PG8_STAGE(PG8_SA(1, 0), cA + kstep, voffA); PG8_STAGE(PG8_SB(1, 1), cB + hstep + kstep, voffB);
        PG8_WAIT_V(6); PG8_BAR;
    }
    for (;;) {
        const bool has_next = S.next(ui + 1, nxt);
        const char* nA = has_next ? (const char*)g.A + (size_t)nxt.pm * tstep : cA; const char* nB = has_next ? (const char*)g.Bt + (size_t)nxt.pn * tstep : cB;
        for (int t = 0; t < nt; t += 2) {
            const bool last = (t == nt - 2);
            const char* a1 = cA + (size_t)(t + 1) * kstep;
            const char* a2 = last ? nA : cA + (size_t)(t + 2) * kstep; const char* b2 = last ? nB : cB + (size_t)(t + 2) * kstep;
            const char* a3 = a2 + kstep; const char* b3 = b2 + kstep;
            if (last && has_next) S.a_ready(nxt);
            if constexpr (SP2) {
            PG8_LDB(B0, 0, 0); PG8_LDB(B1, 0, 1); PG8_SCHED; PG8_LDA(At, 0, 0); PG8_STAGE(PG8_SA(1, 1), a1 + hstep, voffA);
            PG8_WAIT_V(8); PG8_WAIT_L(0); PG8_BAR; PG8_MMA(0, 0, At, B0); PG8_MMA(0, 1, At, B1); PG8_BAR; PG8_SCHED;
            PG8_LDA(At, 0, 1); PG8_STAGE(PG8_SB(0, 0), b2, voffB); PG8_STAGE(PG8_SB(0, 1), b2 + hstep, voffB); PG8_STAGE(PG8_SA(0, 0), a2, voffA);
            PG8_WAIT_V(8); PG8_WAIT_L(0); PG8_BAR; PG8_MMA(1, 0, At, B0); PG8_MMA(1, 1, At, B1); PG8_BAR; PG8_SCHED;
            PG8_LDB(B0, 1, 0); PG8_LDB(B1, 1, 1); PG8_SCHED; PG8_LDA(At, 1, 0); PG8_STAGE(PG8_SA(0, 1), a2 + hstep, voffA);
            PG8_WAIT_V(8); PG8_WAIT_L(0); PG8_BAR; PG8_MMA(0, 0, At, B0); PG8_MMA(0, 1, At, B1); PG8_BAR; PG8_SCHED;
            PG8_LDA(At, 1, 1); PG8_STAGE(PG8_SB(1, 0), b3, voffB); PG8_STAGE(PG8_SB(1, 1), b3 + hstep, voffB); PG8_STAGE(PG8_SA(1, 0), a3, voffA);
            PG8_WAIT_V(8); PG8_WAIT_L(0); PG8_BAR; PG8_MMA(1, 0, At, B0); PG8_MMA(1, 1, At, B1); PG8_BAR; PG8_SCHED;
            } else {
            PG8_LDB(B0, 0, 0); PG8_SCHED; PG8_LDA(At, 0, 0); PG8_STAGE(PG8_SA(1, 1), a1 + hstep, voffA);
            PG8_WAIT_L(8); PG8_BAR; PG8_WAIT_L(0); PG8_MMA(0, 0, At, B0); PG8_BAR; PG8_SCHED;
            PG8_LDB(B1, 0, 1); PG8_STAGE(PG8_SB(0, 0), b2, voffB);
            PG8_BAR; PG8_WAIT_L(0); PG8_MMA(0, 1, At, B1); PG8_BAR;
            PG8_LDA(At, 0, 1); PG8_STAGE(PG8_SA(0, 0), a2, voffA);
            PG8_BAR; PG8_WAIT_L(0); PG8_MMA(1, 0, At, B0); PG8_BAR; PG8_SCHED;
            PG8_STAGE(PG8_SB(0, 1), b2 + hstep, voffB);
            PG8_WAIT_V(6); PG8_BAR; PG8_MMA(1, 1, At, B1); PG8_BAR;
            PG8_LDB(B0, 1, 0); PG8_SCHED; PG8_LDA(At, 1, 0); PG8_STAGE(PG8_SA(0, 1), a2 + hstep, voffA);
            PG8_WAIT_L(8); PG8_BAR; PG8_WAIT_L(0); PG8_MMA(0, 0, At, B0); PG8_BAR; PG8_SCHED;
            PG8_LDB(B1, 1, 1); PG8_STAGE(PG8_SB(1, 0), b3, voffB);
            PG8_BAR; PG8_WAIT_L(0); PG8_MMA(0, 1, At, B1); PG8_BAR;
            PG8_LDA(At, 1, 1); PG8_STAGE(PG8_SA(1, 0), a3, voffA);
            PG8_BAR; PG8_WAIT_L(0); PG8_MMA(1, 0, At, B0); PG8_BAR; PG8_SCHED;
            PG8_STAGE(PG8_SB(1, 1), b3 + hstep, voffB);
            PG8_WAIT_V(6); PG8_BAR; PG8_MMA(1, 1, At, B1); PG8_BAR;
            }
        }
        if constexpr (ALIGN_EPI) { if (wr == 0) PG8_BAR; }
        if constexpr (!Epi::AFTER_DRAIN) { E(acc, cur, wr, wc, fr, fq); S.done(cur); }
        if (!has_next) break;
#pragma unroll
        for (int a = 0; a < 2; ++a)
#pragma unroll
            for (int b = 0; b < 2; ++b)
#pragma unroll
                for (int m = 0; m < 4; ++m)
#pragma unroll
                    for (int n = 0; n < 2; ++n) acc[a][b][m][n] = (f32x4){0.f, 0.f, 0.f, 0.f};
        cur = nxt; cA = nA; cB = nB; ++ui;
        if constexpr (ALIGN_EPI) { if (wr == 1) PG8_BAR; }
    }
    PG8_WAIT_V(0);
    if constexpr (!ALIGN_EPI) { if (wr == 0) PG8_BAR; }
    PG8_BAR;
    if constexpr (Epi::AFTER_DRAIN) { E.fused(acc, cur, wr, wc, fr, fq, lds, wid, lane); S.done(cur); }
#undef PG8_SA
#undef PG8_SB
#undef PG8_STAGE
#undef PG8_LDA
#undef PG8_LDB
#undef PG8_MMA
#undef PG8_WAIT_V
#undef PG8_WAIT_L
#undef PG8_BAR
#undef PG8_SCHED
}
}

namespace att {
typedef __attribute__((address_space(3))) const char* lds_cptr;
typedef __attribute__((address_space(3))) char* lds_ptr;
typedef short s16x4 __attribute__((ext_vector_type(4)));
typedef short v4i16_t __attribute__((ext_vector_type(4)));
typedef unsigned u32x4 __attribute__((ext_vector_type(4)));
typedef float f32x2_t __attribute__((ext_vector_type(2))); typedef __bf16 bf16x2_t __attribute__((ext_vector_type(2)));
constexpr int SLOT = 16384, NSLOT = 3;
constexpr int LDS_K = 0, LDS_V = NSLOT * SLOT, LDS_WS = 2 * NSLOT * SLOT, LDS_STG = LDS_WS + 2048, LDS_END = LDS_STG + 4 * 8192;
constexpr float THR = 8.0f;
#define ATT_SBAR() __builtin_amdgcn_sched_barrier(0)
__device__ __forceinline__ int crow(int r, int hi) { return (r & 3) + 8 * (r >> 2) + 4 * hi; }
__device__ __forceinline__ void glds16(const void* gsrc, unsigned lds_dst) { unsigned keep;
    asm volatile("s_mov_b32 %0, m0\n\ts_mov_b32 m0, %2\n\ts_nop 0\n\tglobal_load_lds_dwordx4 %1, off\n\ts_mov_b32 m0, %0" : "=&s"(keep) : "v"(gsrc), "s"(lds_dst) : "memory"); }
__device__ __forceinline__ unsigned cvtpk_s(float lo, float hi) { f32x2_t v = {lo, hi}; bf16x2_t b = __builtin_convertvector(v, bf16x2_t); return __builtin_bit_cast(unsigned, b); }
__device__ __forceinline__ s16x4 vtr(lds_cptr p) { return __builtin_bit_cast(s16x4, __builtin_amdgcn_ds_read_tr16_b64_v4i16((__attribute__((address_space(3))) v4i16_t*)p)); }
#define ATT_MX3(a, b, c) __builtin_fmaxf(__builtin_fmaxf((a), (b)), (c))
__device__ __forceinline__ float rowmax(const f32x16& p0, const f32x16& p1) {
    float a = ATT_MX3(p0[0], p0[1], p1[0]), b = ATT_MX3(p0[2], p0[3], p1[1]); a = ATT_MX3(a, p1[2], p1[3]);
#pragma unroll
    for (int r = 4; r < 16; r += 4) { a = ATT_MX3(a, p0[r], p0[r + 1]); b = ATT_MX3(b, p0[r + 2], p0[r + 3]); a = ATT_MX3(a, p1[r], p1[r + 1]); b = ATT_MX3(b, p1[r + 2], p1[r + 3]); }
    float m = __builtin_fmaxf(a, b); auto rr = __builtin_amdgcn_permlane32_swap(__float_as_uint(m), __float_as_uint(m), false, false);
    return __builtin_fmaxf(__uint_as_float(rr[0]), __uint_as_float(rr[1])); }

struct Params { const bf16_t* QB; const bf16_t* KB; const bf16_t* VB; const bf16_t* GB; bf16_t* AT; const float* gsub; float lam, lam_init; };

__device__ __forceinline__ void attn_unit(char* shm, const Params& P, int hr0, int kr0, int NT) {
    int tid_ = threadIdx.x; asm volatile("" : "+v"(tid_));
    const int tid = tid_, lane = tid & 63, r32 = lane & 31, hi = lane >> 5; const int wid = __builtin_amdgcn_readfirstlane(tid >> 6);
    const int qblk = wid & 3, m = wid >> 2;
    const unsigned lds0 = (unsigned)(uintptr_t)shm;
    const lds_ptr shm3 = (lds_ptr)shm;
    __attribute__((address_space(3))) float* wsf = (__attribute__((address_space(3))) float*)(shm3 + LDS_WS) + wid * 64;
    const bf16_t* ksrc = P.KB + (size_t)(kr0 + lane) * 512 + wid * 8;
    const bf16_t* vsrc = P.VB + (size_t)(kr0 + 16 * (wid & 3) + (lane >> 2)) * 512 + (wid >> 2) * 32 + (lane & 3) * 8;
    const unsigned kdst = lds0 + LDS_K + wid * 1024, vdst = lds0 + LDS_V + (wid >> 2) * 4096 + (wid & 3) * 1024;
#define ATT_DMA(h_, t_, slotoff) do { const size_t go_ = (size_t)(t_) * (64 * 512) + (h_) * 128; \
        glds16(ksrc + go_, (unsigned)__builtin_amdgcn_readfirstlane(kdst + (slotoff))); glds16(ksrc + go_ + 64, (unsigned)__builtin_amdgcn_readfirstlane(kdst + (slotoff) + 8192)); \
        glds16(vsrc + go_, (unsigned)__builtin_amdgcn_readfirstlane(vdst + (slotoff))); glds16(vsrc + go_ + 64, (unsigned)__builtin_amdgcn_readfirstlane(vdst + (slotoff) + 8192)); } while (0)
#define ATT_WAIT_BAR(N) asm volatile("s_waitcnt vmcnt(" #N ") lgkmcnt(0)\n\ts_barrier" ::: "memory")
    const lds_cptr kp0 = (lds_cptr)shm3 + LDS_K + m * 8192 + hi * 1024 + r32 * 16;
    const lds_cptr vp0 = (lds_cptr)shm3 + LDS_V + ((lane >> 4) & 1) * 32 + (lane & 3) * 8 + (4 * hi + ((lane & 15) >> 2)) * 64;
    const int TT = 4 * NT;
    ATT_DMA(0, 0, 0);
    if (NT > 1) ATT_DMA(0, 1, SLOT); else ATT_DMA(1, 0, SLOT);
    int h = 0, t = 0, sl_cur = 0, sl_nn = 2 * SLOT;
    int h2 = (NT > 2) ? 0 : ((NT == 2) ? 1 : 2), t2 = (NT > 2) ? 2 : 0;
    bf16x8 qr[4]; f32x16 o[4]; float mhat = 0.f, l_reg = 0.f;
    for (int T = 0; T < TT; ++T) {
        if (T == 0) ATT_WAIT_BAR(0); else if (T + 1 < TT) ATT_WAIT_BAR(4); else ATT_WAIT_BAR(0);
        if (T + 2 < TT) ATT_DMA(h2, t2, sl_nn);
        if (t == 0) {
            const bf16_t* qp = P.QB + (size_t)(hr0 + 32 * qblk + r32) * 512 + h * 128 + m * 64 + hi * 8;
#pragma unroll
            for (int d0 = 0; d0 < 4; ++d0) qr[d0] = *(const bf16x8*)(qp + d0 * 16);
#pragma unroll
            for (int d = 0; d < 4; ++d) o[d] = f32x16{};
            mhat = 0.f; l_reg = 0.f;
        }
        f32x16 negm;
#pragma unroll
        for (int r = 0; r < 16; ++r) negm[r] = -mhat;
        f32x16 p0, p1;
        { const lds_cptr kp = kp0 + sl_cur;
#pragma unroll
          for (int d0 = 0; d0 < 4; ++d0) {
              const bf16x8 k0 = *(const __attribute__((address_space(3))) bf16x8*)(kp + d0 * 2048);
              const bf16x8 k1 = *(const __attribute__((address_space(3))) bf16x8*)(kp + d0 * 2048 + 512);
              if (d0 == 0) { p0 = __builtin_amdgcn_mfma_f32_32x32x16_bf16(k0, qr[0], negm, 0, 0, 0); p1 = __builtin_amdgcn_mfma_f32_32x32x16_bf16(k1, qr[0], negm, 0, 0, 0); }
              else { p0 = __builtin_amdgcn_mfma_f32_32x32x16_bf16(k0, qr[d0], p0, 0, 0, 0); p1 = __builtin_amdgcn_mfma_f32_32x32x16_bf16(k1, qr[d0], p1, 0, 0, 0); } } }
        const float rm = rowmax(p0, p1);
        const bool first = (t == 0);
        if (first || __any(rm > THR)) {
            const float dl = first ? rm : __builtin_fmaxf(rm, 0.f); mhat += dl;
#pragma unroll
            for (int r = 0; r < 16; ++r) { p0[r] -= dl; p1[r] -= dl; }
            if (!first) {
                const float f = __builtin_amdgcn_exp2f(-dl); l_reg *= f; if (hi == 0) wsf[r32] = f;
                asm volatile("s_waitcnt lgkmcnt(0)" ::: "memory");
#pragma unroll
                for (int d = 0; d < 4; ++d)
#pragma unroll
                    for (int r = 0; r < 16; ++r) o[d][r] *= wsf[crow(r, hi)];
            }
        }
        float sacc = 0.f;
#pragma unroll
        for (int r = 0; r < 16; ++r) { p0[r] = __builtin_amdgcn_exp2f(p0[r]); p1[r] = __builtin_amdgcn_exp2f(p1[r]); sacc += p0[r] + p1[r]; }
        l_reg += sacc;
        u32x4 pw0, pw1, pw2, pw3;
        pw0 = (u32x4){cvtpk_s(p0[0], p0[1]), cvtpk_s(p0[2], p0[3]), cvtpk_s(p0[4], p0[5]), cvtpk_s(p0[6], p0[7])};
        pw1 = (u32x4){cvtpk_s(p0[8], p0[9]), cvtpk_s(p0[10], p0[11]), cvtpk_s(p0[12], p0[13]), cvtpk_s(p0[14], p0[15])};
        pw2 = (u32x4){cvtpk_s(p1[0], p1[1]), cvtpk_s(p1[2], p1[3]), cvtpk_s(p1[4], p1[5]), cvtpk_s(p1[6], p1[7])};
        pw3 = (u32x4){cvtpk_s(p1[8], p1[9]), cvtpk_s(p1[10], p1[11]), cvtpk_s(p1[12], p1[13]), cvtpk_s(p1[14], p1[15])};
        { const lds_cptr vp = vp0 + sl_cur;
#pragma unroll
          for (int db = 0; db < 4; ++db) {
#pragma unroll
              for (int ks = 0; ks < 4; ++ks) {
                  const s16x4 lo = vtr(vp + db * 4096 + ks * 1024), hh = vtr(vp + db * 4096 + ks * 1024 + 512);
                  const bf16x8 vf = (bf16x8){lo[0], lo[1], lo[2], lo[3], hh[0], hh[1], hh[2], hh[3]};
                  const bf16x8 pa = __builtin_bit_cast(bf16x8, ks == 0 ? pw0 : ks == 1 ? pw1 : ks == 2 ? pw2 : pw3);
                  o[db] = __builtin_amdgcn_mfma_f32_32x32x16_bf16(pa, vf, o[db], 0, 0, 0); } } }
        if (t == NT - 1) {
            { auto rr = __builtin_amdgcn_permlane32_swap(__float_as_uint(l_reg), __float_as_uint(l_reg), false, false); l_reg = __uint_as_float(rr[0]) + __uint_as_float(rr[1]); }
            if (hi == 0) wsf[32 + r32] = l_reg;
            asm volatile("s_waitcnt lgkmcnt(0)" ::: "memory");
            float rli[16];
#pragma unroll
            for (int r = 0; r < 16; ++r) rli[r] = __builtin_amdgcn_rcpf(wsf[32 + crow(r, hi)]) * (m == 1 ? P.lam : 1.0f);
#pragma unroll
            for (int d = 0; d < 4; ++d)
#pragma unroll
                for (int r = 0; r < 16; ++r) o[d][r] *= rli[r];
            __attribute__((address_space(3))) unsigned* stg = (__attribute__((address_space(3))) unsigned*)(shm3 + LDS_STG + qblk * 8192) + lane;
            if (m == 1) {
#pragma unroll
                for (int d = 0; d < 4; ++d)
#pragma unroll
                    for (int r2 = 0; r2 < 8; ++r2) stg[(d * 8 + r2) * 64] = cvtpk_s(o[d][2 * r2], o[d][2 * r2 + 1]);
            }
            asm volatile("s_waitcnt lgkmcnt(0)\n\ts_barrier" ::: "memory");
            if (m == 0) {
                float ss[16];
#pragma unroll
                for (int r = 0; r < 16; ++r) ss[r] = 0.f;
#pragma unroll
                for (int d = 0; d < 4; ++d)
#pragma unroll
                    for (int r2 = 0; r2 < 8; ++r2) { const unsigned w = stg[(d * 8 + r2) * 64];
                        o[d][2 * r2] -= __uint_as_float(w << 16); o[d][2 * r2 + 1] -= __uint_as_float(w & 0xffff0000u);
                        ss[2 * r2] += o[d][2 * r2] * o[d][2 * r2]; ss[2 * r2 + 1] += o[d][2 * r2 + 1] * o[d][2 * r2 + 1]; }
#pragma unroll
                for (int r = 0; r < 16; ++r) { float v = ss[r]; v += __shfl_xor(v, 1); v += __shfl_xor(v, 2); v += __shfl_xor(v, 4); v += __shfl_xor(v, 8); v += __shfl_xor(v, 16);
                    ss[r] = (1.0f / sqrtf(v * (1.f / 128.f) + EPS)) * (1.f - P.lam_init); }
                __attribute__((address_space(3))) bf16_t* tl = (__attribute__((address_space(3))) bf16_t*)(shm3 + LDS_STG + qblk * 8192);
                asm volatile("s_waitcnt lgkmcnt(0)" ::: "memory");
#pragma unroll
                for (int d = 0; d < 4; ++d) { const float gs = P.gsub[32 * d + r32];
#pragma unroll
                    for (int r = 0; r < 16; ++r) tl[crow(r, hi) * 128 + 32 * d + r32] = f2bf(o[d][r] * ss[r] * gs); }
                asm volatile("s_waitcnt lgkmcnt(0)" ::: "memory");
                { const int row = lane >> 1, half = lane & 1; const size_t grow = (size_t)(hr0 + 32 * qblk + row);
                  const bf16_t* gp = P.GB + grow * GW + h * 128 + half * 64; bf16_t* ap = P.AT + grow * DM + h * 128 + half * 64;
                  const __attribute__((address_space(3))) u32x4* tp = (const __attribute__((address_space(3))) u32x4*)(tl + row * 128 + half * 64);
#pragma unroll
                  for (int c = 0; c < 8; ++c) { const u32x4 v = tp[c]; const u32x4 g = *(const u32x4*)(gp + c * 8); u32x4 w;
#pragma unroll
                      for (int e = 0; e < 4; ++e) { const float a0 = __uint_as_float(v[e] << 16) * silu_f(__uint_as_float(g[e] << 16)), a1 = __uint_as_float(v[e] & 0xffff0000u) * silu_f(__uint_as_float(g[e] & 0xffff0000u));
                          w[e] = cvtpk_s(a0, a1); }
                      *(u32x4*)(ap + c * 8) = w; } }
            }
        }
        if (++t == NT) { t = 0; ++h; }
        if (++t2 == NT) { t2 = 0; ++h2; }
        sl_cur = (sl_cur == 2 * SLOT) ? 0 : sl_cur + SLOT; sl_nn = (sl_nn == 2 * SLOT) ? 0 : sl_nn + SLOT;
    }
    asm volatile("s_waitcnt vmcnt(0) lgkmcnt(0)\n\ts_barrier" ::: "memory");
#undef ATT_DMA
#undef ATT_WAIT_BAR
}
}

struct EpiInProj {
    static constexpr bool PERM = true, AFTER_DRAIN = false;
    bf16_t *QB, *KB, *VB, *GB; const float2* rope;
    __device__ __forceinline__ void operator()(const pg8::f32x4 (&acc)[2][2][4][2], const pg8::Unit& u, int wr, int wc, int fr, int fq) const {
        const bool lat = u.pm < 128; const int b = lat ? (u.pm >> 4) : (u.pm - 128); const int t0 = lat ? (u.pm & 15) * 256 : 0;
        const int hr0 = u.pm * 256, kr0 = b * KEYS + (lat ? CTX : 0) + t0, pn = u.pn;
#pragma unroll
        for (int ai = 0; ai < 2; ++ai)
#pragma unroll
            for (int m = 0; m < 4; ++m) {
                const int rl = 128 * ai + 64 * wr + 16 * m + fr, t = t0 + rl;
#pragma unroll
                for (int bj = 0; bj < 2; ++bj) {
                    const int nl = 128 * bj + 32 * wc + 8 * fq;
                    pg8::f32x4 v0 = acc[ai][bj][m][0], v1 = acc[ai][bj][m][1];
                    bf16_t* dst;
                    if (pn < 4) {
                        if (lat) {
                            const int i0 = (nl & 63) >> 1; const int pos = (i0 < 16) ? (t >> 6) : (t & 63);
                            const pg8::f32x4* rp = (const pg8::f32x4*)(rope + pos * 16 + (i0 & 15)); const pg8::f32x4 c0 = rp[0], c1 = rp[1];
                            pg8::f32x4 o0, o1;
                            o0[0] = v0[0] * c0[0] - v0[1] * c0[1]; o0[1] = v0[0] * c0[1] + v0[1] * c0[0]; o0[2] = v0[2] * c0[2] - v0[3] * c0[3]; o0[3] = v0[2] * c0[3] + v0[3] * c0[2];
                            o1[0] = v1[0] * c1[0] - v1[1] * c1[1]; o1[1] = v1[0] * c1[1] + v1[1] * c1[0]; o1[2] = v1[2] * c1[2] - v1[3] * c1[3]; o1[3] = v1[2] * c1[3] + v1[3] * c1[2];
                            v0 = o0; v1 = o1;
                        }
                        if (pn < 2) { v0 = v0 * C2; v1 = v1 * C2; dst = QB + (size_t)(hr0 + rl) * 512 + pn * 256 + nl; }
                        else dst = KB + (size_t)(kr0 + rl) * 512 + (pn - 2) * 256 + nl;
                    } else if (pn < 6) dst = VB + (size_t)(kr0 + rl) * 512 + (pn - 4) * 256 + nl;
                    else dst = GB + (size_t)(hr0 + rl) * GW + (pn - 6) * 256 + nl;
                    pg8::u32x4 w; w.x = pg8::cvt_pk_bf16(v0[0], v0[1]); w.y = pg8::cvt_pk_bf16(v0[2], v0[3]); w.z = pg8::cvt_pk_bf16(v1[0], v1[1]); w.w = pg8::cvt_pk_bf16(v1[2], v1[3]);
                    *(pg8::u32x4*)dst = w;
                }
            }
    }
};
struct InSched {
    pg8::StaticOrder so; int G, c, nctx_cols, ctx_col0;
    __device__ void init(int G_, int c_, int nctx_cols_, int ctx_col0_) { so.init(NLAT, DIN, G_, c_); G = G_; c = c_; nctx_cols = nctx_cols_; ctx_col0 = ctx_col0_; }
    __device__ bool next(int i, pg8::Unit& u) const {
        const int L = i * G + c;
        if (L < 1920) return so.next(i, u);
        const int r = L - 1920; if (r >= 8 * nctx_cols) return false;
        u.pm = 128 + (r & 7); u.pn = ctx_col0 + (r >> 3); return true;
    }
    __device__ __forceinline__ void a_ready(const pg8::Unit&) const {}
    __device__ __forceinline__ void done(const pg8::Unit&) const {}
};

constexpr int LDS_BYTES = 147456;
struct MegaArgs { const float* in[20]; float* out; unsigned char* ws; int ph_lo, ph_hi; };

__global__ void __launch_bounds__(512, 2) mega(MegaArgs a) {
    extern __shared__ __attribute__((aligned(16))) unsigned char lds[];
    cg::grid_group grid = cg::this_grid();
    unsigned char* ws = a.ws;
    bf16_t* WIN = (bf16_t*)(ws + WS_WIN); bf16_t* H = (bf16_t*)(ws + WS_H);
    const int lo = a.ph_lo, hi = a.ph_hi;
#define IN(k) (lo <= (k) && (k) < hi)
#define BOTH(k) (IN(k) && IN((k) + 1))
#pragma unroll 1
    for (int l = 0; l < NL; ++l) {
        const int ph = 2 + 2 * l;
        if (IN(ph)) {
            pg8::Gemm g{H, WIN + (size_t)l * DIN * DM, MROWS, DIN, DM};
            InSched S; S.init((int)gridDim.x, (int)blockIdx.x, l == 0 ? 15 : 4, l == 0 ? 0 : 2);
            EpiInProj E{(bf16_t*)(ws + WS_QB), (bf16_t*)(ws + WS_KB), (bf16_t*)(ws + WS_VB), (bf16_t*)(ws + WS_GB), (const float2*)(ws + WS_ROPE)};
            pg8::gemm_phase<EpiInProj, InSched, true, true>((PG8_LAS unsigned char*)lds, g, S, E);
            if (BOTH(ph)) grid.sync();
        }
        if (IN(ph + 1)) {
            float s1 = 0.f, s2 = 0.f;
            for (int d = 0; d < 64; ++d) { s1 += a.in[8][l * 64 + d] * a.in[9][l * 64 + d]; s2 += a.in[10][l * 64 + d] * a.in[11][l * 64 + d]; }
            const float lam_init = 0.8f - 0.6f * expf(-0.3f * (float)l);
            const float lam = expf(s1) - expf(s2) + lam_init;
            att::Params P{(const bf16_t*)(ws + WS_QB), (const bf16_t*)(ws + WS_KB), (const bf16_t*)(ws + WS_VB), (const bf16_t*)(ws + WS_GB), (bf16_t*)(ws + WS_AT), a.in[12] + l * 128, lam, lam_init};
            __syncthreads();
            const int nun = (l == 0) ? 272 : 256;
#pragma unroll 1
            for (int u = blockIdx.x; u < nun; u += gridDim.x) {
                const bool lat = u < 256; const int v = lat ? u : u - 256; const int b = v & 7, qt = v >> 3;
                att::attn_unit((char*)lds, P, lat ? b * SEQ + qt * 128 : NLAT + b * CTX + qt * 128, b * KEYS, lat ? KEYS / 64 : CTX / 64); }
            if (BOTH(ph + 1)) grid.sync();
        }
    }
#undef IN
#undef BOTH
}

static int launch_mega(MegaArgs& a, int lo, int hi, hipStream_t stream) {
    static int grid = 0;
    if (grid == 0) {
        int dev = 0, cus = 0, per_cu = 0;
        (void)hipGetDevice(&dev); (void)hipDeviceGetAttribute(&cus, hipDeviceAttributeMultiprocessorCount, dev);
        if (hipFuncSetAttribute((const void*)mega, hipFuncAttributeMaxDynamicSharedMemorySize, LDS_BYTES) != hipSuccess) { fprintf(stderr, "hipFuncSetAttribute failed\n"); grid = -1; return -1; }
        (void)hipOccupancyMaxActiveBlocksPerMultiprocessor(&per_cu, (const void*)mega, 512, LDS_BYTES);
        if (per_cu < 1) { fprintf(stderr, "mega: occupancy query says %d blocks/CU\n", per_cu); grid = -1; return -1; }
        grid = cus;
    }
    if (grid < 0) return -1;
    a.ph_lo = lo; a.ph_hi = hi;
    void* args[] = {&a};
    hipError_t e = hipLaunchCooperativeKernel((const void*)mega, dim3(grid), dim3(512), args, LDS_BYTES, stream);
    if (e != hipSuccess) { fprintf(stderr, "cooperative launch failed: %s (grid %d)\n", hipGetErrorString(e), grid); return -1; }
    return 0;
}

extern "C" void kernel_launch(void* const* d_in, const int* in_sizes, int n_in, void* d_out, int out_size, void* d_ws, size_t ws_size, hipStream_t stream) {
    if (n_in != 20 || in_sizes[0] != NLAT * DM || out_size != NLAT * DM || ws_size < WS_END) {
        fprintf(stderr, "kernel_launch: unexpected shapes (n_in %d in0 %d out %d ws %zu)\n", n_in, n_in > 0 ? in_sizes[0] : -1, out_size, ws_size); return; }
    const float* x = (const float*)d_in[0]; const float* c = (const float*)d_in[1]; const float* ctx = (const float*)d_in[2]; const float* cctx = (const float*)d_in[3];
    const float* w_ada = (const float*)d_in[4]; const float* b_ada = (const float*)d_in[5]; const float* g_norm = (const float*)d_in[6]; const float* w_in = (const float*)d_in[7];
    const float* lq1 = (const float*)d_in[8]; const float* lk1 = (const float*)d_in[9]; const float* lq2 = (const float*)d_in[10]; const float* lk2 = (const float*)d_in[11];
    const float* gsub = (const float*)d_in[12]; const float* w_short = (const float*)d_in[13]; const float* w_conf = (const float*)d_in[14]; const float* b_conf = (const float*)d_in[15];
    const float* g_ln = (const float*)d_in[16]; const float* b_ln = (const float*)d_in[17]; const float* w_out = (const float*)d_in[18]; const float* g_final = (const float*)d_in[19];
    unsigned char* ws = (unsigned char*)d_ws; float* out = (float*)d_out;
    float* MOD = (float*)(ws + WS_MOD); float2* ROPE = (float2*)(ws + WS_ROPE);
    bf16_t* WIN = (bf16_t*)(ws + WS_WIN); bf16_t* WOUT = (bf16_t*)(ws + WS_WOUT); bf16_t* H = (bf16_t*)(ws + WS_H);
    bf16_t* QB = (bf16_t*)(ws + WS_QB); bf16_t* KB = (bf16_t*)(ws + WS_KB); bf16_t* VB = (bf16_t*)(ws + WS_VB); bf16_t* GB = (bf16_t*)(ws + WS_GB);
    float* CTX1 = (float*)(ws + WS_CTX1); bf16_t* AT = (bf16_t*)(ws + WS_AT);
    MegaArgs ma{}; for (int i = 0; i < 20; ++i) ma.in[i] = (const float*)d_in[i]; ma.out = out; ma.ws = ws;
    for (int l = 0; l < NL; ++l) {
        k_transpose<<<dim3(DIN / 32, DM / 32), 256, 0, stream>>>(w_in + (size_t)l * DM * DIN, WIN + (size_t)l * DIN * DM, DM, DIN);
        k_transpose<<<dim3(DM / 32, DM / 32), 256, 0, stream>>>(w_out + (size_t)l * DM * DM, WOUT + (size_t)l * DM * DM, DM, DM);
    }
    k_mod<<<dim3(3072 / 64, NL), 256, 0, stream>>>(c, cctx, w_ada, b_ada, MOD);
    k_rope<<<4, 256, 0, stream>>>(ROPE);
    for (int l = 0; l < NL; ++l) {
        const float* xin = l == 0 ? x : out; const float* cin = l == 0 ? ctx : CTX1; const float* modl = MOD + (size_t)l * 9 * 3072;
        k_normmod<<<NLAT / 4, 256, 0, stream>>>(xin, NLAT, SEQ, 0, g_norm + l * DM, modl, H, 0);
        k_normmod<<<NCTX / 4, 256, 0, stream>>>(cin, NCTX, CTX, 1, g_norm + l * DM, modl, H, NLAT);
        if (launch_mega(ma, 2 + 2 * l, 3 + 2 * l, stream)) return;
        if (launch_mega(ma, 3 + 2 * l, 4 + 2 * l, stream)) return;
        k_conv<<<NLAT, 256, 0, stream>>>(GB, AT, w_short, w_conf, b_conf, g_ln, b_ln, l, 0);
        if (l == 0) {
            k_conv<<<NCTX, 256, 0, stream>>>(GB, AT, w_short, w_conf, b_conf, g_ln, b_ln, l, NLAT);
            k_gemm_out<<<dim3(DM / 128, NCTX / 32), 64, 0, stream>>>(AT, WOUT + (size_t)l * DM * DM, ctx, CTX1, modl, NLAT, CTX, 1);
        }
        k_gemm_out<<<dim3(DM / 128, NLAT / 32), 64, 0, stream>>>(AT, WOUT + (size_t)l * DM * DM, xin, out, modl, 0, SEQ, 0);
    }
    k_final<<<NLAT / 4, 256, 0, stream>>>(out, g_final, NLAT);
}
```

```cpp
#include <hip/hip_runtime.h>
#include <stdint.h>
#include <stdio.h>

typedef unsigned short bf16_t;
typedef short bf16x8 __attribute__((ext_vector_type(8)));
typedef float f32x16 __attribute__((ext_vector_type(16)));
typedef float f32x4 __attribute__((ext_vector_type(4)));

constexpr int NB = 8, SEQ = 4096, DM = 1024, NL = 2, CTX = 256, DIN = 3840;
constexpr int NLAT = NB * SEQ;
constexpr int NCTX = NB * CTX;
constexpr int MROWS = NLAT + NCTX;
constexpr int KEYS = CTX + SEQ;
constexpr int GW = 2304;
constexpr float EPS = 1e-6f;
constexpr float C2 = 0.125f * 1.4426950408889634f;

constexpr size_t MiB = 1u << 20;
constexpr size_t WS_CTL = 0;
constexpr size_t WS_MOD = 1 * MiB;
constexpr size_t WS_ROPE = WS_MOD + 512 * 1024;
constexpr size_t WS_WIN = 2 * MiB;
constexpr size_t WS_WOUT = 18 * MiB;
constexpr size_t WS_H = 22 * MiB;
constexpr size_t WS_QB = 94 * MiB;
constexpr size_t WS_KB = 130 * MiB;
constexpr size_t WS_VB = 164 * MiB;
constexpr size_t WS_GB = 198 * MiB;
constexpr size_t WS_CTX1 = 360 * MiB;
constexpr size_t WS_AT = 368 * MiB;
constexpr size_t WS_END = 440 * MiB;

__device__ __forceinline__ float bf2f(bf16_t v) { return __uint_as_float((unsigned)v << 16); }
__device__ __forceinline__ bf16_t f2bf(float f) { unsigned u = __float_as_uint(f); return (bf16_t)((u + 0x7fffu + ((u >> 16) & 1u)) >> 16); }
__device__ __forceinline__ float silu_f(float x) { return x / (1.f + __expf(-x)); }
__device__ __forceinline__ float sigmoid_f(float x) { return 1.f / (1.f + __expf(-x)); }
__device__ __forceinline__ float wave_sum(float v) {
#pragma unroll
    for (int o = 1; o < 64; o <<= 1) v += __shfl_xor(v, o);
    return v;
}

#include <hip/hip_cooperative_groups.h>
namespace cg = cooperative_groups;
namespace pg8 {
#define PG8_LAS __attribute__((address_space(3)))
typedef unsigned short bf16_t;
typedef short bf16x8 __attribute__((ext_vector_type(8)));
typedef float f32x4 __attribute__((ext_vector_type(4)));
typedef unsigned u32x4 __attribute__((ext_vector_type(4)));
constexpr int BM = 256, BK = 64, HALF = 128, HTB = HALF * BK * 2  , STAGE_BYTES = 8 * HTB, NXCD = 8, WGM = 8;

__host__ __device__ __forceinline__ int lds_byte(int r, int c) { const int st = (r >> 4) * 2 + (c >> 5), rr = r & 15, cc = c & 31, ob = rr * 64 + cc * 2; return st * 1024 + (ob ^ (((ob >> 9) & 1) << 5)); }
__host__ __device__ __forceinline__ void stage_rc(int b, int& R, int& C) { const int st = b / 1024, sb = b % 1024, swz = sb ^ (((sb >> 9) & 1) << 5); R = (st >> 1) * 16 + swz / 64; C = (st & 1) * 32 + (swz % 64) / 2; }
__host__ __device__ __forceinline__ int perm32(int rho) { const int n = rho >> 4, i = rho & 15; return 8 * (i >> 2) + 4 * n + (i & 3); }

struct Unit { int pm, pn; };
struct Gemm { const bf16_t* A; const bf16_t* Bt; int M, N, K; };

struct StaticOrder {
    int nM, nN, nwg, G, c;
    __host__ __device__ void init(int M, int N, int G_, int c_) { nM = M / BM; nN = N / BM; nwg = nM * nN; G = G_; c = c_; }
    __host__ __device__ bool next(int i, Unit& u) const {
        const long L = (long)i * G + c; if (L >= nwg) return false;
        int wgid = (int)L; { const int q = nwg / NXCD, r = nwg % NXCD, xcd = wgid % NXCD, off = wgid / NXCD; wgid = (xcd < r ? xcd * (q + 1) : r * (q + 1) + (xcd - r) * q) + off; }
        const int nig = WGM * nN, gid = wgid / nig, fm = gid * WGM, gsz = (nM - fm) < WGM ? (nM - fm) : WGM;
        u.pm = fm + ((wgid % nig) % gsz); u.pn = (wgid % nig) / gsz; return true;
    }
    __device__ __forceinline__ void a_ready(const Unit&) const {}
    __device__ __forceinline__ void done(const Unit&) const {}
};

__device__ __forceinline__ unsigned cvt_pk_bf16(float lo, float hi) { unsigned r; asm volatile("v_cvt_pk_bf16_f32 %0, %1, %2" : "=v"(r) : "v"(lo), "v"(hi)); return r; }
template <class Epi, class Sched, bool ALIGN_EPI = false, bool SP2 = false>
__device__ __forceinline__ void gemm_phase(PG8_LAS unsigned char* lds, const Gemm g, const Sched& S, const Epi& E) {
    int tid_ = threadIdx.x; asm volatile("" : "+v"(tid_));
    const int tid = tid_, wid = __builtin_amdgcn_readfirstlane(tid >> 6), lane = tid & 63, wr = wid >> 2, wc = wid & 3, fr = lane & 15, fq = lane >> 4;
    const int K = g.K, nt = K / BK;
    unsigned voffA[2], voffB[2];
#pragma unroll
    for (int i = 0; i < 2; ++i) { int R, C; stage_rc(tid * 16 + i * 8192, R, C); const int Rb = Epi::PERM ? ((R & ~31) + perm32(R & 31)) : R;
        voffA[i] = (unsigned)(R * K + C) * 2u; voffB[i] = (unsigned)(Rb * K + C) * 2u; }
    const size_t kstep = (size_t)(BK * 2);
    const size_t hstep = (size_t)HALF * K * 2;
    const size_t tstep = 2 * hstep;
    const unsigned ldsw = (unsigned)wid * 1024u;
    const int aoff = lds_byte(wr * 64 + fr, fq * 8), boff = lds_byte(wc * 32 + fr, fq * 8);
#define PG8_SA(b, h) (((b) * 2 + (h)) * HTB)
#define PG8_SB(b, h) ((4 + (b) * 2 + (h)) * HTB)
#define PG8_STAGE(bufoff, gbase, voff) do { _Pragma("unroll") for (int _i = 0; _i < 2; ++_i) \
        __builtin_amdgcn_global_load_lds((const unsigned*)((const char*)(gbase) + (voff)[_i]), (PG8_LAS unsigned*)(lds + (bufoff) + ldsw + _i * 8192), 16, 0, 0); } while (0)
#define PG8_LDA(dst, b, h) do { _Pragma("unroll") for (int m = 0; m < 4; ++m) _Pragma("unroll") for (int k = 0; k < 2; ++k) dst[m][k] = *(const PG8_LAS bf16x8*)(lds + PG8_SA(b, h) + aoff + m * 2048 + k * 1024); } while (0)
#define PG8_LDB(dst, b, h) do { _Pragma("unroll") for (int n = 0; n < 2; ++n) _Pragma("unroll") for (int k = 0; k < 2; ++k) dst[n][k] = *(const PG8_LAS bf16x8*)(lds + PG8_SB(b, h) + boff + n * 2048 + k * 1024); } while (0)
#define PG8_MMA(ai, bj, At, Bt) do { __builtin_amdgcn_s_setprio(1); _Pragma("unroll") for (int m = 0; m < 4; ++m) _Pragma("unroll") for (int n = 0; n < 2; ++n) _Pragma("unroll") for (int k = 0; k < 2; ++k) \
        acc[ai][bj][m][n] = __builtin_amdgcn_mfma_f32_16x16x32_bf16(Bt[n][k], At[m][k], acc[ai][bj][m][n], 0, 0, 0); __builtin_amdgcn_s_setprio(0); } while (0)
#define PG8_WAIT_V(n) asm volatile("s_waitcnt vmcnt(" #n ")" ::: "memory")
#define PG8_WAIT_L(n) asm volatile("s_waitcnt lgkmcnt(" #n ")" ::: "memory")
#define PG8_BAR __builtin_amdgcn_s_barrier()
#define PG8_SCHED __builtin_amdgcn_sched_barrier(0)
    Unit cur, nxt; int ui = 0;
    if (!S.next(0, cur)) return;
    f32x4 acc[2][2][4][2];
#pragma unroll
    for (int a = 0; a < 2; ++a)
#pragma unroll
        for (int b = 0; b < 2; ++b)
#pragma unroll
            for (int m = 0; m < 4; ++m)
#pragma unroll
                for (int n = 0; n < 2; ++n) acc[a][b][m][n] = (f32x4){0.f, 0.f, 0.f, 0.f};
    bf16x8 At[4][2], B0[2][2], B1[2][2];
    const char* cA = (const char*)g.A + (size_t)cur.pm * tstep; const char* cB = (const char*)g.Bt + (size_t)cur.pn * tstep;
    S.a_ready(cur);
    if constexpr (SP2) {
        PG8_STAGE(PG8_SB(0, 0), cB, voffB); PG8_STAGE(PG8_SB(0, 1), cB + hstep, voffB); PG8_STAGE(PG8_SA(0, 0), cA, voffA); PG8_STAGE(PG8_SA(0, 1), cA + hstep, voffA);
        if (wr == 1) PG8_BAR;
        PG8_WAIT_V(2); PG8_BAR;
        PG8_STAGE(PG8_SB(1, 0), cB + kstep, voffB); PG8_STAGE(PG8_SA(1, 0), cA + kstep, voffA); PG8_STAGE(PG8_SB(1, 1), cB + hstep + kstep, voffB);
        PG8_WAIT_V(6); PG8_BAR;
    } else {
        PG8_STAGE(PG8_SB(0, 0), cB, voffB); PG8_STAGE(PG8_SA(0, 0), cA, voffA); PG8_STAGE(PG8_SB(0, 1), cB + hstep, voffB); PG8_STAGE(PG8_SA(0, 1), cA + hstep, voffA);
        if (wr == 1) PG8_BAR;
        PG8_WAIT_V(4); PG8_BAR;
        PG8_STAGE(PG8_SB(1, 0), cB + kstep, voffB); PG8_STAGE(PG8_SA(1, 0), cA + kstep, voffA); PG8_STAGE(PG8_SB(1, 1), cB + hstep + kstep, voffB);
        PG8_WAIT_V(6); PG8_BAR;
    }
    for (;;) {
        const bool has_next = S.next(ui + 1, nxt);
        const char* nA = has_next ? (const char*)g.A + (size_t)nxt.pm * tstep : cA; const char* nB = has_next ? (const char*)g.Bt + (size_t)nxt.pn * tstep : cB;
        for (int t = 0; t < nt; t += 2) {
            const bool last = (t == nt - 2);
            const char* a1 = cA + (size_t)(t + 1) * kstep;
            const char* a2 = last ? nA : cA + (size_t)(t + 2) * kstep; const char* b2 = last ? nB : cB + (size_t)(t + 2) * kstep;
            const char* a3 = a2 + kstep; const char* b3 = b2 + kstep;
            if (last && has_next) S.a_ready(nxt);
            if constexpr (SP2) {
            PG8_LDB(B0, 0, 0); PG8_LDB(B1, 0, 1); PG8_SCHED; PG8_LDA(At, 0, 0); PG8_STAGE(PG8_SA(1, 1), a1 + hstep, voffA);
            PG8_WAIT_V(8); PG8_WAIT_L(0); PG8_BAR; PG8_MMA(0, 0, At, B0); PG8_MMA(0, 1, At, B1); PG8_BAR; PG8_SCHED;
            PG8_LDA(At, 0, 1); PG8_STAGE(PG8_SB(0, 0), b2, voffB); PG8_STAGE(PG8_SB(0, 1), b2 + hstep, voffB); PG8_STAGE(PG8_SA(0, 0), a2, voffA);
            PG8_WAIT_V(8); PG8_WAIT_L(0); PG8_BAR; PG8_MMA(1, 0, At, B0); PG8_MMA(1, 1, At, B1); PG8_BAR; PG8_SCHED;
            PG8_LDB(B0, 1, 0); PG8_LDB(B1, 1, 1); PG8_SCHED; PG8_LDA(At, 1, 0); PG8_STAGE(PG8_SA(0, 1), a2 + hstep, voffA);
            PG8_WAIT_V(8); PG8_WAIT_L(0); PG8_BAR; PG8_MMA(0, 0, At, B0); PG8_MMA(0, 1, At, B1); PG8_BAR; PG8_SCHED;
            PG8_LDA(At, 1, 1); PG8_STAGE(PG8_SB(1, 0), b3, voffB); PG8_STAGE(PG8_SB(1, 1), b3 + hstep, voffB); PG8_STAGE(PG8_SA(1, 0), a3, voffA);
            PG8_WAIT_V(8); PG8_WAIT_L(0); PG8_BAR; PG8_MMA(1, 0, At, B0); PG8_MMA(1, 1, At, B1); PG8_BAR; PG8_SCHED;
            } else {
            PG8_LDB(B0, 0, 0); PG8_SCHED; PG8_LDA(At, 0, 0); PG8_STAGE(PG8_SA(1, 1), a1 + hstep, voffA);
            PG8_WAIT_L(8); PG8_BAR; PG8_WAIT_L(0); PG8_MMA(0, 0, At, B0); PG8_BAR; PG8_SCHED;
            PG8_LDB(B1, 0, 1); PG8_STAGE(PG8_SB(0, 0), b2, voffB);
            PG8_BAR; PG8_WAIT_L(0); PG8_MMA(0, 1, At, B1); PG8_BAR;
            PG8_LDA(At, 0, 1); PG8_STAGE(PG8_SA(0, 0), a2, voffA);
            PG8_BAR; PG8_WAIT_L(0); PG8_MMA(1, 0, At, B0); PG8_BAR; PG8_SCHED;
            PG8_STAGE(PG8_SB(0, 1), b2 + hstep, voffB);
            PG8_WAIT_V(6); PG8_BAR; PG8_MMA(1, 1, At, B1); PG8_BAR;
            PG8_LDB(B0, 1, 0); PG8_SCHED; PG8_LDA(At, 1, 0); PG8_STAGE(PG8_SA(0, 1), a2 + hstep, voffA);
            PG8_WAIT_L(8); PG8_BAR; PG8_WAIT_L(0); PG8_MMA(0, 0, At, B0); PG8_BAR; PG8_SCHED;
            PG8_LDB(B1, 1, 1); PG8_STAGE(PG8_SB(1, 0), b3, voffB);
            PG8_BAR; PG8_WAIT_L(0); PG8_MMA(0, 1, At, B1); PG8_BAR;
            PG8_LDA(At, 1, 1); PG8_STAGE(PG8_SA(1, 0), a3, voffA);
            PG8_BAR; PG8_WAIT_L(0); PG8_MMA(1, 0, At, B0); PG8_BAR; PG8_SCHED;
            PG8_STAGE(PG8_SB(1, 1), b3 + hstep, voffB);
            PG8_WAIT_V(6); PG8_BAR; PG8_MMA(1, 1, At, B1); PG8_BAR;
            }
        }
        if constexpr (ALIGN_EPI) { if (wr == 0) PG8_BAR; }
        if constexpr (!Epi::AFTER_DRAIN) { E(acc, cur, wr, wc, fr, fq); S.done(cur); }
        if (!has_next) break;
#pragma unroll
        for (int a = 0; a < 2; ++a)
#pragma unroll
            for (int b = 0; b < 2; ++b)
#pragma unroll
                for (int m = 0; m < 4; ++m)
#pragma unroll
                    for (int n = 0; n < 2; ++n) acc[a][b][m][n] = (f32x4){0.f, 0.f, 0.f, 0.f};
        cur = nxt; cA = nA; cB = nB; ++ui;
        if constexpr (ALIGN_EPI) { if (wr == 1) PG8_BAR; }
    }
    PG8_WAIT_V(0);
    if constexpr (!ALIGN_EPI) { if (wr == 0) PG8_BAR; }
    PG8_BAR;
    if constexpr (Epi::AFTER_DRAIN) { E.fused(acc, cur, wr, wc, fr, fq, lds, wid, lane); S.done(cur); }
#undef PG8_SA
#undef PG8_SB
#undef PG8_STAGE
#undef PG8_LDA
#undef PG8_LDB
#undef PG8_MMA
#undef PG8_WAIT_V
#undef PG8_WAIT_L
#undef PG8_BAR
#undef PG8_SCHED
}
}

namespace att {
typedef __attribute__((address_space(3))) const char* lds_cptr;
typedef __attribute__((address_space(3))) char* lds_ptr;
typedef short s16x4 __attribute__((ext_vector_type(4)));
typedef short v4i16_t __attribute__((ext_vector_type(4)));
typedef unsigned u32x4 __attribute__((ext_vector_type(4)));
typedef float f32x2_t __attribute__((ext_vector_type(2))); typedef __bf16 bf16x2_t __attribute__((ext_vector_type(2)));
constexpr int SLOT = 16384, NSLOT = 3;
constexpr int LDS_K = 0, LDS_V = NSLOT * SLOT, LDS_WS = 2 * NSLOT * SLOT, LDS_STG = LDS_WS + 2048, LDS_END = LDS_STG + 4 * 8192;
constexpr float THR = 8.0f;
#define ATT_SBAR() __builtin_amdgcn_sched_barrier(0)
__device__ __forceinline__ int crow(int r, int hi) { return (r & 3) + 8 * (r >> 2) + 4 * hi; }
__device__ __forceinline__ void glds16(const void* gsrc, unsigned lds_dst) { unsigned keep;
    asm volatile("s_mov_b32 %0, m0\n\ts_mov_b32 m0, %2\n\ts_nop 0\n\tglobal_load_lds_dwordx4 %1, off\n\ts_mov_b32 m0, %0" : "=&s"(keep) : "v"(gsrc), "s"(lds_dst) : "memory"); }
__device__ __forceinline__ unsigned cvtpk_s(float lo, float hi) { f32x2_t v = {lo, hi}; bf16x2_t b = __builtin_convertvector(v, bf16x2_t); return __builtin_bit_cast(unsigned, b); }
__device__ __forceinline__ s16x4 vtr(lds_cptr p) { return __builtin_bit_cast(s16x4, __builtin_amdgcn_ds_read_tr16_b64_v4i16((__attribute__((address_space(3))) v4i16_t*)p)); }
#define ATT_MX3(a, b, c) __builtin_fmaxf(__builtin_fmaxf((a), (b)), (c))
__device__ __forceinline__ float rowmax(const f32x16& p0, const f32x16& p1) {
    float a = ATT_MX3(p0[0], p0[1], p1[0]), b = ATT_MX3(p0[2], p0[3], p1[1]); a = ATT_MX3(a, p1[2], p1[3]);
#pragma unroll
    for (int r = 4; r < 16; r += 4) { a = ATT_MX3(a, p0[r], p0[r + 1]); b = ATT_MX3(b, p0[r + 2], p0[r + 3]); a = ATT_MX3(a, p1[r], p1[r + 1]); b = ATT_MX3(b, p1[r + 2], p1[r + 3]); }
    float m = __builtin_fmaxf(a, b); auto rr = __builtin_amdgcn_permlane32_swap(__float_as_uint(m), __float_as_uint(m), false, false);
    return __builtin_fmaxf(__uint_as_float(rr[0]), __uint_as_float(rr[1])); }

struct Params { const bf16_t* QB; const bf16_t* KB; const bf16_t* VB; const bf16_t* GB; bf16_t* AT; const float* gsub; float lam, lam_init; };

__device__ __forceinline__ void attn_unit(char* shm, const Params& P, int hr0, int kr0, int NT) {
    int tid_ = threadIdx.x; asm volatile("" : "+v"(tid_));
    const int tid = tid_, lane = tid & 63, r32 = lane & 31, hi = lane >> 5; const int wid = __builtin_amdgcn_readfirstlane(tid >> 6);
    const int qblk = wid & 3, m = wid >> 2;
    const unsigned lds0 = (unsigned)(uintptr_t)shm;
    const lds_ptr shm3 = (lds_ptr)shm;
    __attribute__((address_space(3))) float* wsf = (__attribute__((address_space(3))) float*)(shm3 + LDS_WS) + wid * 64;
    const bf16_t* ksrc = P.KB + (size_t)(kr0 + lane) * 512 + wid * 8;
    const bf16_t* vsrc = P.VB + (size_t)(kr0 + 16 * (wid & 3) + (lane >> 2)) * 512 + (wid >> 2) * 32 + (lane & 3) * 8;
    const unsigned kdst = lds0 + LDS_K + wid * 1024, vdst = lds0 + LDS_V + (wid >> 2) * 4096 + (wid & 3) * 1024;
#define ATT_DMA(h_, t_, slotoff) do { const size_t go_ = (size_t)(t_) * (64 * 512) + (h_) * 128; \
        glds16(ksrc + go_, (unsigned)__builtin_amdgcn_readfirstlane(kdst + (slotoff))); glds16(ksrc + go_ + 64, (unsigned)__builtin_amdgcn_readfirstlane(kdst + (slotoff) + 8192)); \
        glds16(vsrc + go_, (unsigned)__builtin_amdgcn_readfirstlane(vdst + (slotoff))); glds16(vsrc + go_ + 64, (unsigned)__builtin_amdgcn_readfirstlane(vdst + (slotoff) + 8192)); } while (0)
#define ATT_WAIT_BAR(N) asm volatile("s_waitcnt vmcnt(" #N ") lgkmcnt(0)\n\ts_barrier" ::: "memory")
    const lds_cptr kp0 = (lds_cptr)shm3 + LDS_K + m * 8192 + hi * 1024 + r32 * 16;
    const lds_cptr vp0 = (lds_cptr)shm3 + LDS_V + ((lane >> 4) & 1) * 32 + (lane & 3) * 8 + (4 * hi + ((lane & 15) >> 2)) * 64;
    const int TT = 4 * NT;
    ATT_DMA(0, 0, 0);
    if (NT > 1) ATT_DMA(0, 1, SLOT); else ATT_DMA(1, 0, SLOT);
    int h = 0, t = 0, sl_cur = 0, sl_nn = 2 * SLOT;
    int h2 = (NT > 2) ? 0 : ((NT == 2) ? 1 : 2), t2 = (NT > 2) ? 2 : 0;
    bf16x8 qr[4]; f32x16 o[4]; float mhat = 0.f, l_reg = 0.f;
    for (int T = 0; T < TT; ++T) {
        if (T == 0) ATT_WAIT_BAR(0); else if (T + 1 < TT) ATT_WAIT_BAR(4); else ATT_WAIT_BAR(0);
        if (T + 2 < TT) ATT_DMA(h2, t2, sl_nn);
        if (t == 0) {
            const bf16_t* qp = P.QB + (size_t)(hr0 + 32 * qblk + r32) * 512 + h * 128 + m * 64 + hi * 8;
#pragma unroll
            for (int d0 = 0; d0 < 4; ++d0) qr[d0] = *(const bf16x8*)(qp + d0 * 16);
#pragma unroll
            for (int d = 0; d < 4; ++d) o[d] = f32x16{};
            mhat = 0.f; l_reg = 0.f;
        }
        f32x16 negm;
#pragma unroll
        for (int r = 0; r < 16; ++r) negm[r] = -mhat;
        f32x16 p0, p1;
        { const lds_cptr kp = kp0 + sl_cur;
#pragma unroll
          for (int d0 = 0; d0 < 4; ++d0) {
              const bf16x8 k0 = *(const __attribute__((address_space(3))) bf16x8*)(kp + d0 * 2048);
              const bf16x8 k1 = *(const __attribute__((address_space(3))) bf16x8*)(kp + d0 * 2048 + 512);
              if (d0 == 0) { p0 = __builtin_amdgcn_mfma_f32_32x32x16_bf16(k0, qr[0], negm, 0, 0, 0); p1 = __builtin_amdgcn_mfma_f32_32x32x16_bf16(k1, qr[0], negm, 0, 0, 0); }
              else { p0 = __builtin_amdgcn_mfma_f32_32x32x16_bf16(k0, qr[d0], p0, 0, 0, 0); p1 = __builtin_amdgcn_mfma_f32_32x32x16_bf16(k1, qr[d0], p1, 0, 0, 0); } } }
        const float rm = rowmax(p0, p1);
        const bool first = (t == 0);
        if (first || __any(rm > THR)) {
            const float dl = first ? rm : __builtin_fmaxf(rm, 0.f); mhat += dl;
#pragma unroll
            for (int r = 0; r < 16; ++r) { p0[r] -= dl; p1[r] -= dl; }
            if (!first) {
                const float f = __builtin_amdgcn_exp2f(-dl); l_reg *= f; if (hi == 0) wsf[r32] = f;
                asm volatile("s_waitcnt lgkmcnt(0)" ::: "memory");
#pragma unroll
                for (int d = 0; d < 4; ++d)
#pragma unroll
                    for (int r = 0; r < 16; ++r) o[d][r] *= wsf[crow(r, hi)];
            }
        }
        float sacc = 0.f;
#pragma unroll
        for (int r = 0; r < 16; ++r) { p0[r] = __builtin_amdgcn_exp2f(p0[r]); p1[r] = __builtin_amdgcn_exp2f(p1[r]); sacc += p0[r] + p1[r]; }
        l_reg += sacc;
        u32x4 pw0, pw1, pw2, pw3;
        pw0 = (u32x4){cvtpk_s(p0[0], p0[1]), cvtpk_s(p0[2], p0[3]), cvtpk_s(p0[4], p0[5]), cvtpk_s(p0[6], p0[7])};
        pw1 = (u32x4){cvtpk_s(p0[8], p0[9]), cvtpk_s(p0[10], p0[11]), cvtpk_s(p0[12], p0[13]), cvtpk_s(p0[14], p0[15])};
        pw2 = (u32x4){cvtpk_s(p1[0], p1[1]), cvtpk_s(p1[2], p1[3]), cvtpk_s(p1[4], p1[5]), cvtpk_s(p1[6], p1[7])};
        pw3 = (u32x4){cvtpk_s(p1[8], p1[9]), cvtpk_s(p1[10], p1[11]), cvtpk_s(p1[12], p1[13]), cvtpk_s(p1[14], p1[15])};
        { const lds_cptr vp = vp0 + sl_cur;
#pragma unroll
          for (int db = 0; db < 4; ++db) {
#pragma unroll
              for (int ks = 0; ks < 4; ++ks) {
                  const s16x4 lo = vtr(vp + db * 4096 + ks * 1024), hh = vtr(vp + db * 4096 + ks * 1024 + 512);
                  const bf16x8 vf = (bf16x8){lo[0], lo[1], lo[2], lo[3], hh[0], hh[1], hh[2], hh[3]};
                  const bf16x8 pa = __builtin_bit_cast(bf16x8, ks == 0 ? pw0 : ks == 1 ? pw1 : ks == 2 ? pw2 : pw3);
                  o[db] = __builtin_amdgcn_mfma_f32_32x32x16_bf16(pa, vf, o[db], 0, 0, 0); } } }
        if (t == NT - 1) {
            { auto rr = __builtin_amdgcn_permlane32_swap(__float_as_uint(l_reg), __float_as_uint(l_reg), false, false); l_reg = __uint_as_float(rr[0]) + __uint_as_float(rr[1]); }
            if (hi == 0) wsf[32 + r32] = l_reg;
            asm volatile("s_waitcnt lgkmcnt(0)" ::: "memory");
            float rli[16];
#pragma unroll
            for (int r = 0; r < 16; ++r) rli[r] = __builtin_amdgcn_rcpf(wsf[32 + crow(r, hi)]) * (m == 1 ? P.lam : 1.0f);
#pragma unroll
            for (int d = 0; d < 4; ++d)
#pragma unroll
                for (int r = 0; r < 16; ++r) o[d][r] *= rli[r];
            __attribute__((address_space(3))) unsigned* stg = (__attribute__((address_space(3))) unsigned*)(shm3 + LDS_STG + qblk * 8192) + lane;
            if (m == 1) {
#pragma unroll
                for (int d = 0; d < 4; ++d)
#pragma unroll
                    for (int r2 = 0; r2 < 8; ++r2) stg[(d * 8 + r2) * 64] = cvtpk_s(o[d][2 * r2], o[d][2 * r2 + 1]);
            }
            asm volatile("s_waitcnt lgkmcnt(0)\n\ts_barrier" ::: "memory");
            if (m == 0) {
                float ss[16];
#pragma unroll
                for (int r = 0; r < 16; ++r) ss[r] = 0.f;
#pragma unroll
                for (int d = 0; d < 4; ++d)
#pragma unroll
                    for (int r2 = 0; r2 < 8; ++r2) { const unsigned w = stg[(d * 8 + r2) * 64];
                        o[d][2 * r2] -= __uint_as_float(w << 16); o[d][2 * r2 + 1] -= __uint_as_float(w & 0xffff0000u);
                        ss[2 * r2] += o[d][2 * r2] * o[d][2 * r2]; ss[2 * r2 + 1] += o[d][2 * r2 + 1] * o[d][2 * r2 + 1]; }
#pragma unroll
                for (int r = 0; r < 16; ++r) { float v = ss[r]; v += __shfl_xor(v, 1); v += __shfl_xor(v, 2); v += __shfl_xor(v, 4); v += __shfl_xor(v, 8); v += __shfl_xor(v, 16);
                    ss[r] = (1.0f / sqrtf(v * (1.f / 128.f) + EPS)) * (1.f - P.lam_init); }
                __attribute__((address_space(3))) bf16_t* tl = (__attribute__((address_space(3))) bf16_t*)(shm3 + LDS_STG + qblk * 8192);
                asm volatile("s_waitcnt lgkmcnt(0)" ::: "memory");
#pragma unroll
                for (int d = 0; d < 4; ++d) { const float gs = P.gsub[32 * d + r32];
#pragma unroll
                    for (int r = 0; r < 16; ++r) tl[crow(r, hi) * 128 + 32 * d + r32] = f2bf(o[d][r] * ss[r] * gs); }
                asm volatile("s_waitcnt lgkmcnt(0)" ::: "memory");
                { const int row = lane >> 1, half = lane & 1; const size_t grow = (size_t)(hr0 + 32 * qblk + row);
                  const bf16_t* gp = P.GB + grow * GW + h * 128 + half * 64; bf16_t* ap = P.AT + grow * DM + h * 128 + half * 64;
                  const __attribute__((address_space(3))) u32x4* tp = (const __attribute__((address_space(3))) u32x4*)(tl + row * 128 + half * 64);
#pragma unroll
                  for (int c = 0; c < 8; ++c) { const u32x4 v = tp[c]; const u32x4 g = *(const u32x4*)(gp + c * 8); u32x4 w;
#pragma unroll
                      for (int e = 0; e < 4; ++e) { const float a0 = __uint_as_float(v[e] << 16) * silu_f(__uint_as_float(g[e] << 16)), a1 = __uint_as_float(v[e] & 0xffff0000u) * silu_f(__uint_as_float(g[e] & 0xffff0000u));
                          w[e] = cvtpk_s(a0, a1); }
                      *(u32x4*)(ap + c * 8) = w; } }
            }
        }
        if (++t == NT) { t = 0; ++h; }
        if (++t2 == NT) { t2 = 0; ++h2; }
        sl_cur = (sl_cur == 2 * SLOT) ? 0 : sl_cur + SLOT; sl_nn = (sl_nn == 2 * SLOT) ? 0 : sl_nn + SLOT;
    }
    asm volatile("s_waitcnt vmcnt(0) lgkmcnt(0)\n\ts_barrier" ::: "memory");
#undef ATT_DMA
#undef ATT_WAIT_BAR
}
}

namespace tail {
typedef __attribute__((address_space(3))) char* lds_ptr;
typedef unsigned u32x4 __attribute__((ext_vector_type(4)));
__device__ __forceinline__ void unpack8(const u32x4 v, float (&f)[8]) {
#pragma unroll
    for (int e = 0; e < 4; ++e) { f[2 * e] = __uint_as_float(v[e] << 16); f[2 * e + 1] = __uint_as_float(v[e] & 0xffff0000u); } }
__device__ __forceinline__ u32x4 pack8(const float (&f)[8]) { u32x4 w;
#pragma unroll
    for (int e = 0; e < 4; ++e) w[e] = att::cvtpk_s(f[2 * e], f[2 * e + 1]);
    return w; }

struct Unit { int hr0;
              int t0, len;
              int mrow;
              const float* xin; float* xout; };

__device__ __forceinline__ void conv_b(const bf16_t* GB, bf16_t* AT, const float* wsh, const Unit& U, int tid) {
    const int cv = tid & 31, tg = tid >> 5, c0 = 8 * cv;
    float w[3][8];
#pragma unroll
    for (int j = 0; j < 3; ++j)
#pragma unroll
        for (int e = 0; e < 8; ++e) w[j][e] = wsh[j * 256 + c0 + e];
    float pm[8], pc[8], pn[8];
    auto prod = [&](int tl, float (&p)[8]) {
        const int t = U.t0 + tl;
        if (t >= 0 && t < U.len) { const bf16_t* g = GB + (size_t)(U.hr0 + tl) * GW; float a[8], b[8]; unpack8(*(const u32x4*)(g + 768 + c0), a); unpack8(*(const u32x4*)(g + 1024 + c0), b);
#pragma unroll
            for (int e = 0; e < 8; ++e) p[e] = a[e] * b[e]; }
        else {
#pragma unroll
            for (int e = 0; e < 8; ++e) p[e] = 0.f; } };
    prod(8 * tg - 1, pm); prod(8 * tg, pc);
#pragma unroll
    for (int i = 0; i < 8; ++i) {
        const int tl = 8 * tg + i; prod(tl + 1, pn);
        const bf16_t* g = GB + (size_t)(U.hr0 + tl) * GW; float bb[8], gb[8], y[8]; unpack8(*(const u32x4*)(g + 512 + c0), bb); unpack8(*(const u32x4*)(g + 1280 + c0), gb);
#pragma unroll
        for (int e = 0; e < 8; ++e) { const float acc = w[0][e] * pm[e] + w[1][e] * pc[e] + w[2][e] * pn[e]; y[e] = bb[e] * acc * silu_f(gb[e]); }
        *(u32x4*)(AT + (size_t)(U.hr0 + tl) * DM + 512 + c0) = pack8(y);
#pragma unroll
        for (int e = 0; e < 8; ++e) { pm[e] = pc[e]; pc[e] = pn[e]; }
    }
}

__device__ __forceinline__ void conv_c(char* shm, const bf16_t* GB, bf16_t* AT, const float* wcf, const float* bcf, const float* gln, const float* bln, const Unit& U, int tid) {
    const lds_ptr shm3 = (lds_ptr)shm;
    const int cvh = tid & 15, tg = tid >> 4;
    float v[2][4][8];
#pragma unroll
    for (int hf = 0; hf < 2; ++hf) {
        for (int item = tid; item < 160 * 16; item += 512) {
            const int i = item >> 4, cq = item & 15, t = U.t0 - 15 + i; float u[8];
            if (t >= 0 && t < U.len) { const bf16_t* g = GB + (size_t)(U.hr0 - 15 + i) * GW + 128 * hf + 8 * cq; float a[8], b[8]; unpack8(*(const u32x4*)(g + 1536), a); unpack8(*(const u32x4*)(g + 1792), b);
#pragma unroll
                for (int e = 0; e < 8; ++e) u[e] = a[e] * sigmoid_f(b[e]); }
            else {
#pragma unroll
                for (int e = 0; e < 8; ++e) u[e] = 0.f; }
            __attribute__((address_space(3))) f32x4* d = (__attribute__((address_space(3))) f32x4*)(shm3 + (size_t)(i * 128 + 8 * cq) * 4);
            d[0] = (f32x4){u[0], u[1], u[2], u[3]}; d[1] = (f32x4){u[4], u[5], u[6], u[7]};
        }
        __syncthreads();
        const int c0 = 128 * hf + 8 * cvh;
#pragma unroll
        for (int tt = 0; tt < 4; ++tt)
#pragma unroll
            for (int e = 0; e < 8; ++e) v[hf][tt][e] = bcf[c0 + e];
#pragma unroll 1
        for (int jb = 0; jb < 8; ++jb) {
            float ur[7][8];
#pragma unroll
            for (int q = 0; q < 7; ++q) { const __attribute__((address_space(3))) f32x4* s = (const __attribute__((address_space(3))) f32x4*)(shm3 + (size_t)((4 * tg + 4 * jb + q) * 128 + 8 * cvh) * 4);
                const f32x4 u0 = s[0], u1 = s[1]; ur[q][0] = u0[0]; ur[q][1] = u0[1]; ur[q][2] = u0[2]; ur[q][3] = u0[3]; ur[q][4] = u1[0]; ur[q][5] = u1[1]; ur[q][6] = u1[2]; ur[q][7] = u1[3]; }
#pragma unroll
            for (int jj = 0; jj < 4; ++jj) { const int j = 4 * jb + jj; const int jc = j < 31 ? j : 30; const float wm = j < 31 ? 1.f : 0.f;
                const f32x4 w0 = *(const f32x4*)(wcf + jc * 256 + c0) * wm, w1 = *(const f32x4*)(wcf + jc * 256 + c0 + 4) * wm;
#pragma unroll
                for (int tt = 0; tt < 4; ++tt) {
                    v[hf][tt][0] += w0[0] * ur[tt + jj][0]; v[hf][tt][1] += w0[1] * ur[tt + jj][1]; v[hf][tt][2] += w0[2] * ur[tt + jj][2]; v[hf][tt][3] += w0[3] * ur[tt + jj][3];
                    v[hf][tt][4] += w1[0] * ur[tt + jj][4]; v[hf][tt][5] += w1[1] * ur[tt + jj][5]; v[hf][tt][6] += w1[2] * ur[tt + jj][6]; v[hf][tt][7] += w1[3] * ur[tt + jj][7]; } }
        }
        __syncthreads();
    }
#pragma unroll
    for (int tt = 0; tt < 4; ++tt) {
        float s1 = 0.f;
#pragma unroll
        for (int hf = 0; hf < 2; ++hf)
#pragma unroll
            for (int e = 0; e < 8; ++e) s1 += v[hf][tt][e];
        s1 += __shfl_xor(s1, 1); s1 += __shfl_xor(s1, 2); s1 += __shfl_xor(s1, 4); s1 += __shfl_xor(s1, 8);
        const float mean = s1 * (1.f / 256.f); float s2 = 0.f;
#pragma unroll
        for (int hf = 0; hf < 2; ++hf)
#pragma unroll
            for (int e = 0; e < 8; ++e) { const float d = v[hf][tt][e] - mean; s2 += d * d; }
        s2 += __shfl_xor(s2, 1); s2 += __shfl_xor(s2, 2); s2 += __shfl_xor(s2, 4); s2 += __shfl_xor(s2, 8);
        const float rstd = 1.0f / sqrtf(s2 * (1.f / 256.f) + EPS);
        const int tl = 4 * tg + tt;
#pragma unroll
        for (int hf = 0; hf < 2; ++hf) { const int c0 = 128 * hf + 8 * cvh; float gc[8], y[8]; unpack8(*(const u32x4*)(GB + (size_t)(U.hr0 + tl) * GW + 2048 + c0), gc);
#pragma unroll
            for (int e = 0; e < 8; ++e) { const float z = (v[hf][tt][e] - mean) * rstd * gln[c0 + e] + bln[c0 + e]; y[e] = silu_f(z) * silu_f(gc[e]); }
            *(u32x4*)(AT + (size_t)(U.hr0 + tl) * DM + 768 + c0) = pack8(y); }
    }
}

constexpr int OP_BUF = 49152, OP_A = 0, OP_B = 16384;
__device__ __forceinline__ void outproj(char* shm, const bf16_t* A, const bf16_t* WT, const Unit& U, const float* gt, int tid) {
    const int lane = tid & 63, r32 = lane & 31, hi = lane >> 5; const int wid = __builtin_amdgcn_readfirstlane(tid >> 6), wr = wid >> 2, wc = wid & 3;
    const unsigned lds0 = (unsigned)(uintptr_t)shm; const lds_ptr shm3 = (lds_ptr)shm;
    const bf16_t* asrc0 = A + (size_t)(64 * (wid & 1) + lane) * DM + 8 * (wid >> 1);
    const unsigned adst0 = lds0 + OP_A + (wid >> 1) * 2048 + (wid & 1) * 1024;
    const bf16_t* bsrc0 = WT + (size_t)(64 * (wid & 3) + lane) * DM + 8 * (wid >> 2);
    const unsigned bdst0 = lds0 + OP_B + (wid >> 2) * 4096 + (wid & 3) * 1024;
#define OP_STAGE(s_, buf_) do { const int ch_ = (s_) >> 4, kt_ = (s_) & 15; const unsigned bo_ = (buf_) * OP_BUF; \
        att::glds16(asrc0 + kt_ * 64, (unsigned)__builtin_amdgcn_readfirstlane(adst0 + bo_)); att::glds16(asrc0 + kt_ * 64 + 32, (unsigned)__builtin_amdgcn_readfirstlane(adst0 + bo_ + 4 * 2048)); \
        _Pragma("unroll") for (int i_ = 0; i_ < 4; ++i_) att::glds16(bsrc0 + (size_t)ch_ * 256 * DM + kt_ * 64 + 16 * i_, (unsigned)__builtin_amdgcn_readfirstlane(bdst0 + bo_ + 2 * i_ * 4096)); } while (0)
    f32x16 acc[2][2];
    OP_STAGE(0, 0);
    for (int s = 0; s < 64; ++s) {
        const int buf = s & 1;
        asm volatile("s_waitcnt vmcnt(0) lgkmcnt(0)\n\ts_barrier" ::: "memory");
        if (s + 1 < 64) OP_STAGE(s + 1, buf ^ 1);
        if ((s & 15) == 0) {
#pragma unroll
            for (int a = 0; a < 2; ++a)
#pragma unroll
                for (int b = 0; b < 2; ++b) acc[a][b] = f32x16{};
        }
        const lds_ptr ab = shm3 + buf * OP_BUF + OP_A + hi * 2048 + (64 * wr + r32) * 16, bb = shm3 + buf * OP_BUF + OP_B + hi * 4096 + (64 * wc + r32) * 16;
#pragma unroll
        for (int ks = 0; ks < 4; ++ks) {
            bf16x8 af[2], bfr[2];
#pragma unroll
            for (int mt = 0; mt < 2; ++mt) af[mt] = *(const __attribute__((address_space(3))) bf16x8*)(ab + ks * 2 * 2048 + mt * 512);
#pragma unroll
            for (int nt = 0; nt < 2; ++nt) bfr[nt] = *(const __attribute__((address_space(3))) bf16x8*)(bb + ks * 2 * 4096 + nt * 512);
#pragma unroll
            for (int mt = 0; mt < 2; ++mt)
#pragma unroll
                for (int nt = 0; nt < 2; ++nt) acc[mt][nt] = __builtin_amdgcn_mfma_f32_32x32x16_bf16(af[mt], bfr[nt], acc[mt][nt], 0, 0, 0);
        }
        if ((s & 15) == 15) {
            const int ch = s >> 4;
#pragma unroll
            for (int nt = 0; nt < 2; ++nt) { const int n = 256 * ch + 64 * wc + 32 * nt + r32; const float g = gt[n];
#pragma unroll
                for (int mt = 0; mt < 2; ++mt)
#pragma unroll
                    for (int r = 0; r < 16; ++r) { const size_t off = (size_t)(64 * wr + 32 * mt + att::crow(r, hi)) * DM + n; U.xout[off] = U.xin[off] + g * acc[mt][nt][r]; } }
        }
    }
#undef OP_STAGE
}

__device__ __forceinline__ void rowpass(const Unit& U, bool last, const float* g, const float* modn, bf16_t* H, int tid) {
    const int lane = tid & 63; const int wid = __builtin_amdgcn_readfirstlane(tid >> 6);
    for (int rr = 0; rr < 16; ++rr) {
        const int row = wid * 16 + rr;
        f32x4* xr = (f32x4*)(U.xout + (size_t)row * DM) + lane;
        f32x4 v[4]; float ss = 0.f;
#pragma unroll
        for (int j = 0; j < 4; ++j) { v[j] = xr[64 * j]; ss += (v[j].x * v[j].x + v[j].y * v[j].y) + (v[j].z * v[j].z + v[j].w * v[j].w); }
        const float rstd = 1.0f / sqrtf(wave_sum(ss) * (1.f / DM) + EPS);
        if (last) {
#pragma unroll
            for (int j = 0; j < 4; ++j) { const f32x4 gg = *(const f32x4*)(g + 4 * lane + 256 * j); f32x4 o = v[j] * rstd; o.x *= gg.x; o.y *= gg.y; o.z *= gg.z; o.w *= gg.w; xr[64 * j] = o; }
        } else {
            const float* sh = modn + (size_t)U.mrow * 3072; const float* sc = sh + 1024; bf16_t* o = H + (size_t)(U.hr0 + row) * DM;
#pragma unroll
            for (int j = 0; j < 4; ++j) { const int k = 4 * lane + 256 * j;
                const f32x4 gg = *(const f32x4*)(g + k), s1 = *(const f32x4*)(sc + k), s0 = *(const f32x4*)(sh + k);
                ushort4 w; w.x = f2bf(v[j].x * rstd * gg.x * (1.f + s1.x) + s0.x); w.y = f2bf(v[j].y * rstd * gg.y * (1.f + s1.y) + s0.y);
                w.z = f2bf(v[j].z * rstd * gg.z * (1.f + s1.z) + s0.z); w.w = f2bf(v[j].w * rstd * gg.w * (1.f + s1.w) + s0.w);
                *(ushort4*)(o + k) = w; }
        }
    }
}
}

namespace pro {
typedef __attribute__((address_space(3))) float* lds_f;
__device__ __forceinline__ void transpose_item(const float* W, int K, int N, bf16_t* WT, lds_f scr, int item, int lane) {
    const int nblk = N / 32, kb = item / nblk, nb = item % nblk, k0 = 64 * kb, n0 = 32 * nb;
#pragma unroll 8
    for (int i = 0; i < 32; ++i) { const int kk = 2 * i + (lane >> 5); scr[kk * 33 + (lane & 31)] = W[(size_t)(k0 + kk) * N + n0 + (lane & 31)]; }
    asm volatile("s_waitcnt lgkmcnt(0)" ::: "memory");
    const int c = lane & 7;
#pragma unroll
    for (int j = 0; j < 4; ++j) { const int n = (lane >> 3) + 8 * j; const lds_f s = scr + (8 * c) * 33 + n;
        att::u32x4 o; o.x = att::cvtpk_s(s[0 * 33], s[1 * 33]); o.y = att::cvtpk_s(s[2 * 33], s[3 * 33]); o.z = att::cvtpk_s(s[4 * 33], s[5 * 33]); o.w = att::cvtpk_s(s[6 * 33], s[7 * 33]);
        *(att::u32x4*)(WT + (size_t)(n0 + n) * K + k0 + 8 * c) = o; }
    asm volatile("s_waitcnt lgkmcnt(0)" ::: "memory");
}
__device__ __forceinline__ void p0(char* shm, const float* const* in, unsigned char* ws, int tid, int nblocks) {
    const int lane = tid & 63; const int wave = __builtin_amdgcn_readfirstlane(tid >> 6);
    const __attribute__((address_space(3))) char* shm3c = (const __attribute__((address_space(3))) char*)shm; (void)shm3c;
    __attribute__((address_space(3))) char* shm3 = (__attribute__((address_space(3))) char*)shm;
    if (blockIdx.x < 96) {
        lds_f s = (lds_f)shm3;
        lds_f red = (lds_f)(shm3 + 36864);
        const float* c = in[1]; const float* cctx = in[3];
        for (int i = tid; i < 9 * 1024; i += 512) { const int r = i >> 10, k = i & 1023; const float v = r < 8 ? c[r * 1024 + k] : cctx[k]; s[i] = silu_f(v); }
        __syncthreads();
        const int l = blockIdx.x / 48, n = 64 * (blockIdx.x % 48) + (tid & 63), kq = tid >> 6;
        float acc[9];
#pragma unroll
        for (int r = 0; r < 9; ++r) acc[r] = 0.f;
        const float* w = in[4] + (size_t)l * 1024 * 3072 + n;
#pragma unroll 4
        for (int k = kq * 128; k < kq * 128 + 128; ++k) { const float wv = w[(size_t)k * 3072];
#pragma unroll
            for (int r = 0; r < 9; ++r) acc[r] += s[r * 1024 + k] * wv; }
#pragma unroll
        for (int r = 0; r < 9; ++r) red[(kq * 9 + r) * 64 + (tid & 63)] = acc[r];
        __syncthreads();
        if (tid < 64) {
            float* MOD = (float*)(ws + WS_MOD);
#pragma unroll
            for (int r = 0; r < 9; ++r) { float v = 0.f;
#pragma unroll
                for (int q = 0; q < 8; ++q) v += red[(q * 9 + r) * 64 + tid];
                MOD[((size_t)l * 9 + r) * 3072 + n] = v + in[5][l * 3072 + n]; }
        }
        __syncthreads();
    }
    if ((int)blockIdx.x == nblocks - 1) {
        for (int i = tid; i < 1024; i += 512) {
            const int pos = i >> 4, f = i & 15;
            double inv = 1.0; for (int j = 0; j < f; ++j) inv *= 0.5623413251903491;
            const double ang = (double)pos * inv, hp = 1.5707963267948966;
            const double kq = __builtin_floor(ang / hp + 0.5); const double r = ang - kq * hp - kq * 6.123233995736766e-17;
            const double r2 = r * r;
            const double sn = r * (1.0 + r2 * (-1.0 / 6 + r2 * (1.0 / 120 + r2 * (-1.0 / 5040 + r2 * (1.0 / 362880 + r2 * (-1.0 / 39916800 + r2 * (1.0 / 6227020800.0 + r2 * (-1.0 / 1307674368000.0))))))));
            const double cs = 1.0 + r2 * (-0.5 + r2 * (1.0 / 24 + r2 * (-1.0 / 720 + r2 * (1.0 / 40320 + r2 * (-1.0 / 3628800 + r2 * (1.0 / 479001600.0 + r2 * (-1.0 / 87178291200.0 + r2 * (1.0 / 20922789888000.0))))))));
            const int q = ((int)kq) & 3; double co, si;
            if (q == 0) { co = cs; si = sn; } else if (q == 1) { co = -sn; si = cs; } else if (q == 2) { co = -cs; si = -sn; } else { co = sn; si = -cs; }
            ((float2*)(ws + WS_ROPE))[i] = make_float2((float)co, (float)si);
        }
    }
    lds_f scr = (lds_f)(shm3 + 65536 + wave * 8448);
    constexpr int I_IN = (DM / 64) * (DIN / 32), I_OUT = (DM / 64) * (DM / 32), I_L = I_IN + I_OUT;
    const int gw = (int)blockIdx.x * 8 + wave, NGW = nblocks * 8;
    for (int it = gw; it < NL * I_L; it += NGW) {
        const int l = it / I_L, r = it % I_L;
        if (r < I_IN) transpose_item(in[7] + (size_t)l * DM * DIN, DM, DIN, (bf16_t*)(ws + WS_WIN) + (size_t)l * DIN * DM, scr, r, lane);
        else transpose_item(in[18] + (size_t)l * DM * DM, DM, DM, (bf16_t*)(ws + WS_WOUT) + (size_t)l * DM * DM, scr, r - I_IN, lane);
    }
}
__device__ __forceinline__ void p1(const float* const* in, unsigned char* ws, int tid, int nblocks) {
    const int lane = tid & 63; const int wave = __builtin_amdgcn_readfirstlane(tid >> 6);
    const float* MOD0 = (const float*)(ws + WS_MOD); const float* g = in[6]; bf16_t* H = (bf16_t*)(ws + WS_H);
    for (int hr = (int)blockIdx.x * 8 + wave; hr < MROWS; hr += nblocks * 8) {
        const bool lat = hr < NLAT; const float* src = lat ? in[0] + (size_t)hr * DM : in[2] + (size_t)(hr - NLAT) * DM; const int mrow = lat ? (hr >> 12) : 8;
        const f32x4* xr = (const f32x4*)src + lane;
        f32x4 v[4]; float ss = 0.f;
#pragma unroll
        for (int j = 0; j < 4; ++j) { v[j] = xr[64 * j]; ss += (v[j].x * v[j].x + v[j].y * v[j].y) + (v[j].z * v[j].z + v[j].w * v[j].w); }
        const float rstd = 1.0f / sqrtf(wave_sum(ss) * (1.f / DM) + EPS);
        const float* sh = MOD0 + (size_t)mrow * 3072; const float* sc = sh + 1024; bf16_t* o = H + (size_t)hr * DM;
#pragma unroll
        for (int j = 0; j < 4; ++j) { const int k = 4 * lane + 256 * j;
            const f32x4 gg = *(const f32x4*)(g + k), s1 = *(const f32x4*)(sc + k), s0 = *(const f32x4*)(sh + k);
            ushort4 w; w.x = f2bf(v[j].x * rstd * gg.x * (1.f + s1.x) + s0.x); w.y = f2bf(v[j].y * rstd * gg.y * (1.f + s1.y) + s0.y);
            w.z = f2bf(v[j].z * rstd * gg.z * (1.f + s1.z) + s0.z); w.w = f2bf(v[j].w * rstd * gg.w * (1.f + s1.w) + s0.w);
            *(ushort4*)(o + k) = w; }
    }
}
}

struct EpiInProj {
    static constexpr bool PERM = true, AFTER_DRAIN = false;
    bf16_t *QB, *KB, *VB, *GB; const float2* rope;
    __device__ __forceinline__ void operator()(const pg8::f32x4 (&acc)[2][2][4][2], const pg8::Unit& u, int wr, int wc, int fr, int fq) const {
        const bool lat = u.pm < 128; const int b = lat ? (u.pm >> 4) : (u.pm - 128); const int t0 = lat ? (u.pm & 15) * 256 : 0;
        const int hr0 = u.pm * 256, kr0 = b * KEYS + (lat ? CTX : 0) + t0, pn = u.pn;
#pragma unroll
        for (int ai = 0; ai < 2; ++ai)
#pragma unroll
            for (int m = 0; m < 4; ++m) {
                const int rl = 128 * ai + 64 * wr + 16 * m + fr, t = t0 + rl;
#pragma unroll
                for (int bj = 0; bj < 2; ++bj) {
                    const int nl = 128 * bj + 32 * wc + 8 * fq;
                    pg8::f32x4 v0 = acc[ai][bj][m][0], v1 = acc[ai][bj][m][1];
                    bf16_t* dst;
                    if (pn < 4) {
                        if (lat) {
                            const int i0 = (nl & 63) >> 1; const int pos = (i0 < 16) ? (t >> 6) : (t & 63);
                            const pg8::f32x4* rp = (const pg8::f32x4*)(rope + pos * 16 + (i0 & 15)); const pg8::f32x4 c0 = rp[0], c1 = rp[1];
                            pg8::f32x4 o0, o1;
                            o0[0] = v0[0] * c0[0] - v0[1] * c0[1]; o0[1] = v0[0] * c0[1] + v0[1] * c0[0]; o0[2] = v0[2] * c0[2] - v0[3] * c0[3]; o0[3] = v0[2] * c0[3] + v0[3] * c0[2];
                            o1[0] = v1[0] * c1[0] - v1[1] * c1[1]; o1[1] = v1[0] * c1[1] + v1[1] * c1[0]; o1[2] = v1[2] * c1[2] - v1[3] * c1[3]; o1[3] = v1[2] * c1[3] + v1[3] * c1[2];
                            v0 = o0; v1 = o1;
                        }
                        if (pn < 2) { v0 = v0 * C2; v1 = v1 * C2; dst = QB + (size_t)(hr0 + rl) * 512 + pn * 256 + nl; }
                        else dst = KB + (size_t)(kr0 + rl) * 512 + (pn - 2) * 256 + nl;
                    } else if (pn < 6) dst = VB + (size_t)(kr0 + rl) * 512 + (pn - 4) * 256 + nl;
                    else dst = GB + (size_t)(hr0 + rl) * GW + (pn - 6) * 256 + nl;
                    pg8::u32x4 w; w.x = pg8::cvt_pk_bf16(v0[0], v0[1]); w.y = pg8::cvt_pk_bf16(v0[2], v0[3]); w.z = pg8::cvt_pk_bf16(v1[0], v1[1]); w.w = pg8::cvt_pk_bf16(v1[2], v1[3]);
                    *(pg8::u32x4*)dst = w;
                }
            }
    }
};
struct InSched {
    pg8::StaticOrder so; int G, c, nctx_cols, ctx_col0;
    __device__ void init(int G_, int c_, int nctx_cols_, int ctx_col0_) { so.init(NLAT, DIN, G_, c_); G = G_; c = c_; nctx_cols = nctx_cols_; ctx_col0 = ctx_col0_; }
    __device__ bool next(int i, pg8::Unit& u) const {
        const int L = i * G + c;
        if (L < 1920) return so.next(i, u);
        const int r = L - 1920; if (r >= 8 * nctx_cols) return false;
        u.pm = 128 + (r & 7); u.pn = ctx_col0 + (r >> 3); return true;
    }
    __device__ __forceinline__ void a_ready(const pg8::Unit&) const {}
    __device__ __forceinline__ void done(const pg8::Unit&) const {}
};

constexpr int LDS_BYTES = 147456;
struct MegaArgs { const float* in[20]; float* out; unsigned char* ws; int ph_lo, ph_hi; };

__global__ void __launch_bounds__(512, 2) mega(MegaArgs a) {
    extern __shared__ __attribute__((aligned(16))) unsigned char lds[];
    cg::grid_group grid = cg::this_grid();
    unsigned char* ws = a.ws;
    bf16_t* WIN = (bf16_t*)(ws + WS_WIN); bf16_t* H = (bf16_t*)(ws + WS_H);
    const int lo = a.ph_lo, hi = a.ph_hi;
#define IN(k) (lo <= (k) && (k) < hi)
#define BOTH(k) (IN(k) && IN((k) + 1))
    if (IN(0)) { int tid_ = threadIdx.x; asm volatile("" : "+v"(tid_)); pro::p0((char*)lds, a.in, ws, tid_, (int)gridDim.x); if (BOTH(0)) grid.sync(); }
    if (IN(1)) { int tid_ = threadIdx.x; asm volatile("" : "+v"(tid_)); pro::p1(a.in, ws, tid_, (int)gridDim.x); if (BOTH(1)) grid.sync(); }
#pragma unroll 1
    for (int l = 0; l < NL; ++l) {
        const int ph = 2 + 2 * l;
        if (IN(ph)) {
            pg8::Gemm g{H, WIN + (size_t)l * DIN * DM, MROWS, DIN, DM};
            InSched S; S.init((int)gridDim.x, (int)blockIdx.x, l == 0 ? 15 : 4, l == 0 ? 0 : 2);
            EpiInProj E{(bf16_t*)(ws + WS_QB), (bf16_t*)(ws + WS_KB), (bf16_t*)(ws + WS_VB), (bf16_t*)(ws + WS_GB), (const float2*)(ws + WS_ROPE)};
            pg8::gemm_phase<EpiInProj, InSched, true, true>((PG8_LAS unsigned char*)lds, g, S, E);
            if (BOTH(ph)) grid.sync();
        }
        if (IN(ph + 1)) {
            float s1 = 0.f, s2 = 0.f;
            for (int d = 0; d < 64; ++d) { s1 += a.in[8][l * 64 + d] * a.in[9][l * 64 + d]; s2 += a.in[10][l * 64 + d] * a.in[11][l * 64 + d]; }
            const float lam_init = 0.8f - 0.6f * expf(-0.3f * (float)l);
            const float lam = expf(s1) - expf(s2) + lam_init;
            att::Params P{(const bf16_t*)(ws + WS_QB), (const bf16_t*)(ws + WS_KB), (const bf16_t*)(ws + WS_VB), (const bf16_t*)(ws + WS_GB), (bf16_t*)(ws + WS_AT), a.in[12] + l * 128, lam, lam_init};
            __syncthreads();
            const int nun = (l == 0) ? 272 : 256;
            const bool last = (l == NL - 1);
            const float* MODl = (const float*)(ws + WS_MOD) + (size_t)l * 9 * 3072; const float* MODn = (const float*)(ws + WS_MOD) + (size_t)(last ? l : l + 1) * 9 * 3072;
            const bf16_t* WOUTl = (const bf16_t*)(ws + WS_WOUT) + (size_t)l * DM * DM;
#pragma unroll 1
            for (int u = blockIdx.x; u < nun; u += gridDim.x) {
                const bool lat = u < 256; const int v = lat ? u : u - 256; const int b = v & 7, qt = v >> 3;
                tail::Unit U; U.hr0 = lat ? b * SEQ + qt * 128 : NLAT + b * CTX + qt * 128; U.t0 = qt * 128; U.len = lat ? SEQ : CTX; U.mrow = lat ? b : 8;
                U.xin = lat ? ((l == 0 ? a.in[0] : (const float*)a.out) + (size_t)U.hr0 * DM) : (a.in[2] + (size_t)(b * CTX + qt * 128) * DM);
                U.xout = lat ? (a.out + (size_t)U.hr0 * DM) : ((float*)(ws + WS_CTX1) + (size_t)(b * CTX + qt * 128) * DM);
                att::attn_unit((char*)lds, P, U.hr0, b * KEYS, lat ? KEYS / 64 : CTX / 64);
                int tid_ = threadIdx.x; asm volatile("" : "+v"(tid_)); const int tid = tid_;
                tail::conv_b(P.GB, P.AT, a.in[13] + l * 3 * 256, U, tid);
                tail::conv_c((char*)lds, P.GB, P.AT, a.in[14] + l * 31 * 256, a.in[15] + l * 256, a.in[16] + l * 256, a.in[17] + l * 256, U, tid);
                asm volatile("s_waitcnt vmcnt(0)" ::: "memory"); __syncthreads();
                tail::outproj((char*)lds, P.AT + (size_t)U.hr0 * DM, WOUTl, U, MODl + (size_t)U.mrow * 3072 + 2048, tid);
                asm volatile("s_waitcnt vmcnt(0)" ::: "memory"); __syncthreads();
                tail::rowpass(U, last && lat, last ? a.in[19] : a.in[6] + (l + 1) * DM, MODn, (bf16_t*)(ws + WS_H), tid);
            }
            if (BOTH(ph + 1)) grid.sync();
        }
    }
#undef IN
#undef BOTH
}

static int launch_mega(MegaArgs& a, int lo, int hi, hipStream_t stream) {
    static int grid = 0;
    if (grid == 0) {
        int dev = 0, cus = 0, per_cu = 0;
        (void)hipGetDevice(&dev); (void)hipDeviceGetAttribute(&cus, hipDeviceAttributeMultiprocessorCount, dev);
        if (hipFuncSetAttribute((const void*)mega, hipFuncAttributeMaxDynamicSharedMemorySize, LDS_BYTES) != hipSuccess) { fprintf(stderr, "hipFuncSetAttribute failed\n"); grid = -1; return -1; }
        (void)hipOccupancyMaxActiveBlocksPerMultiprocessor(&per_cu, (const void*)mega, 512, LDS_BYTES);
        if (per_cu < 1) { fprintf(stderr, "mega: occupancy query says %d blocks/CU\n", per_cu); grid = -1; return -1; }
        grid = cus;
    }
    if (grid < 0) return -1;
    a.ph_lo = lo; a.ph_hi = hi;
    void* args[] = {&a};
    hipError_t e = hipLaunchCooperativeKernel((const void*)mega, dim3(grid), dim3(512), args, LDS_BYTES, stream);
    if (e != hipSuccess) { fprintf(stderr, "cooperative launch failed: %s (grid %d)\n", hipGetErrorString(e), grid); return -1; }
    return 0;
}

extern "C" void kernel_launch(void* const* d_in, const int* in_sizes, int n_in, void* d_out, int out_size, void* d_ws, size_t ws_size, hipStream_t stream) {
    if (n_in != 20 || in_sizes[0] != NLAT * DM || out_size != NLAT * DM || ws_size < WS_END) {
        fprintf(stderr, "kernel_launch: unexpected shapes (n_in %d in0 %d out %d ws %zu)\n", n_in, n_in > 0 ? in_sizes[0] : -1, out_size, ws_size); return; }
    MegaArgs ma{}; for (int i = 0; i < 20; ++i) ma.in[i] = (const float*)d_in[i]; ma.out = (float*)d_out; ma.ws = (unsigned char*)d_ws;
    (void)launch_mega(ma, 0, 6, stream);
}
```

```cpp
#include <hip/hip_runtime.h>
#include <stdint.h>
#include <stdio.h>

typedef unsigned short bf16_t;
typedef short bf16x8 __attribute__((ext_vector_type(8)));
typedef float f32x16 __attribute__((ext_vector_type(16)));
typedef float f32x4 __attribute__((ext_vector_type(4)));

constexpr int NB = 8, SEQ = 4096, DM = 1024, NL = 2, CTX = 256, DIN = 3840;
constexpr int NLAT = NB * SEQ;
constexpr int NCTX = NB * CTX;
constexpr int MROWS = NLAT + NCTX;
constexpr int KEYS = CTX + SEQ;
constexpr int GW = 2304;
constexpr float EPS = 1e-6f;
constexpr float C2 = 0.125f * 1.4426950408889634f;

constexpr size_t MiB = 1u << 20;
constexpr size_t WS_CTL = 0;
constexpr size_t WS_MOD = 1 * MiB;
constexpr size_t WS_ROPE = WS_MOD + 512 * 1024;
constexpr size_t WS_WIN = 2 * MiB;
constexpr size_t WS_WOUT = 18 * MiB;
constexpr size_t WS_H = 22 * MiB;
constexpr size_t WS_QB = 94 * MiB;
constexpr size_t WS_KB = 130 * MiB;
constexpr size_t WS_VB = 164 * MiB;
constexpr size_t WS_GB = 198 * MiB;
constexpr size_t WS_CTX1 = 360 * MiB;
constexpr size_t WS_AT = 368 * MiB;
constexpr size_t WS_END = 440 * MiB;

__device__ __forceinline__ float bf2f(bf16_t v) { return __uint_as_float((unsigned)v << 16); }
__device__ __forceinline__ bf16_t f2bf(float f) { unsigned u = __float_as_uint(f); return (bf16_t)((u + 0x7fffu + ((u >> 16) & 1u)) >> 16); }
__device__ __forceinline__ float silu_f(float x) { return x / (1.f + __expf(-x)); }
__device__ __forceinline__ float sigmoid_f(float x) { return 1.f / (1.f + __expf(-x)); }
__device__ __forceinline__ float wave_sum(float v) {
#pragma unroll
    for (int o = 1; o < 64; o <<= 1) v += __shfl_xor(v, o);
    return v;
}

#include <hip/hip_cooperative_groups.h>
namespace cg = cooperative_groups;
namespace pg8 {
#define PG8_LAS __attribute__((address_space(3)))
typedef unsigned short bf16_t;
typedef short bf16x8 __attribute__((ext_vector_type(8)));
typedef float f32x4 __attribute__((ext_vector_type(4)));
typedef unsigned u32x4 __attribute__((ext_vector_type(4)));
constexpr int BM = 256, BK = 64, HALF = 128, HTB = HALF * BK * 2  , STAGE_BYTES = 8 * HTB, NXCD = 8, WGM = 8;

__host__ __device__ __forceinline__ int lds_byte(int r, int c) { const int st = (r >> 4) * 2 + (c >> 5), rr = r & 15, cc = c & 31, ob = rr * 64 + cc * 2; return st * 1024 + (ob ^ (((ob >> 9) & 1) << 5)); }
__host__ __device__ __forceinline__ void stage_rc(int b, int& R, int& C) { const int st = b / 1024, sb = b % 1024, swz = sb ^ (((sb >> 9) & 1) << 5); R = (st >> 1) * 16 + swz / 64; C = (st & 1) * 32 + (swz % 64) / 2; }
__host__ __device__ __forceinline__ int perm32(int rho) { const int n = rho >> 4, i = rho & 15; return 8 * (i >> 2) + 4 * n + (i & 3); }

struct Unit { int pm, pn; };
struct Gemm { const bf16_t* A; const bf16_t* Bt; int M, N, K; };

struct StaticOrder {
    int nM, nN, nwg, G, c;
    __host__ __device__ void init(int M, int N, int G_, int c_) { nM = M / BM; nN = N / BM; nwg = nM * nN; G = G_; c = c_; }
    __host__ __device__ bool next(int i, Unit& u) const {
        const long L = (long)i * G + c; if (L >= nwg) return false;
        int wgid = (int)L; { const int q = nwg / NXCD, r = nwg % NXCD, xcd = wgid % NXCD, off = wgid / NXCD; wgid = (xcd < r ? xcd * (q + 1) : r * (q + 1) + (xcd - r) * q) + off; }
        const int nig = WGM * nN, gid = wgid / nig, fm = gid * WGM, gsz = (nM - fm) < WGM ? (nM - fm) : WGM;
        u.pm = fm + ((wgid % nig) % gsz); u.pn = (wgid % nig) / gsz; return true;
    }
    __device__ __forceinline__ void a_ready(const Unit&) const {}
    __device__ __forceinline__ void done(const Unit&) const {}
};

__device__ __forceinline__ unsigned cvt_pk_bf16(float lo, float hi) { unsigned r; asm volatile("v_cvt_pk_bf16_f32 %0, %1, %2" : "=v"(r) : "v"(lo), "v"(hi)); return r; }
template <class Epi, class Sched, bool ALIGN_EPI = false, bool SP2 = false>
__device__ __forceinline__ void gemm_phase(PG8_LAS unsigned char* lds, const Gemm g, const Sched& S, const Epi& E) {
    int tid_ = threadIdx.x; asm volatile("" : "+v"(tid_));
    const int tid = tid_, wid = __builtin_amdgcn_readfirstlane(tid >> 6), lane = tid & 63, wr = wid >> 2, wc = wid & 3, fr = lane & 15, fq = lane >> 4;
    const int K = g.K, nt = K / BK;
    unsigned voffA[2], voffB[2];
#pragma unroll
    for (int i = 0; i < 2; ++i) { int R, C; stage_rc(tid * 16 + i * 8192, R, C); const int Rb = Epi::PERM ? ((R & ~31) + perm32(R & 31)) : R;
        voffA[i] = (unsigned)(R * K + C) * 2u; voffB[i] = (unsigned)(Rb * K + C) * 2u; }
    const size_t kstep = (size_t)(BK * 2);
    const size_t hstep = (size_t)HALF * K * 2;
    const size_t tstep = 2 * hstep;
    const unsigned ldsw = (unsigned)wid * 1024u;
    const int aoff = lds_byte(wr * 64 + fr, fq * 8), boff = lds_byte(wc * 32 + fr, fq * 8);
#define PG8_SA(b, h) (((b) * 2 + (h)) * HTB)
#define PG8_SB(b, h) ((4 + (b) * 2 + (h)) * HTB)
#define PG8_STAGE(bufoff, gbase, voff) do { _Pragma("unroll") for (int _i = 0; _i < 2; ++_i) \
        __builtin_amdgcn_global_load_lds((const unsigned*)((const char*)(gbase) + (voff)[_i]), (PG8_LAS unsigned*)(lds + (bufoff) + ldsw + _i * 8192), 16, 0, 0); } while (0)
#define PG8_LDA(dst, b, h) do { _Pragma("unroll") for (int m = 0; m < 4; ++m) _Pragma("unroll") for (int k = 0; k < 2; ++k) dst[m][k] = *(const PG8_LAS bf16x8*)(lds + PG8_SA(b, h) + aoff + m * 2048 + k * 1024); } while (0)
#define PG8_LDB(dst, b, h) do { _Pragma("unroll") for (int n = 0; n < 2; ++n) _Pragma("unroll") for (int k = 0; k < 2; ++k) dst[n][k] = *(const PG8_LAS bf16x8*)(lds + PG8_SB(b, h) + boff + n * 2048 + k * 1024); } while (0)
#define PG8_MMA(ai, bj, At, Bt) do { __builtin_amdgcn_s_setprio(1); _Pragma("unroll") for (int m = 0; m < 4; ++m) _Pragma("unroll") for (int n = 0; n < 2; ++n) _Pragma("unroll") for (int k = 0; k < 2; ++k) \
        acc[ai][bj][m][n] = __builtin_amdgcn_mfma_f32_16x16x32_bf16(Bt[n][k], At[m][k], acc[ai][bj][m][n], 0, 0, 0); __builtin_amdgcn_s_setprio(0); } while (0)
#define PG8_WAIT_V(n) asm volatile("s_waitcnt vmcnt(" #n ")" ::: "memory")
#define PG8_WAIT_L(n) asm volatile("s_waitcnt lgkmcnt(" #n ")" ::: "memory")
#define PG8_BAR __builtin_amdgcn_s_barrier()
#define PG8_SCHED __builtin_amdgcn_sched_barrier(0)
    Unit cur, nxt; int ui = 0;
    if (!S.next(0, cur)) return;
    f32x4 acc[2][2][4][2];
#pragma unroll
    for (int a = 0; a < 2; ++a)
#pragma unroll
        for (int b = 0; b < 2; ++b)
#pragma unroll
            for (int m = 0; m < 4; ++m)
#pragma unroll
                for (int n = 0; n < 2; ++n) acc[a][b][m][n] = (f32x4){0.f, 0.f, 0.f, 0.f};
    bf16x8 At[4][2], B0[2][2], B1[2][2];
    const char* cA = (const char*)g.A + (size_t)cur.pm * tstep; const char* cB = (const char*)g.Bt + (size_t)cur.pn * tstep;
    S.a_ready(cur);
    if constexpr (SP2) {
        PG8_STAGE(PG8_SB(0, 0), cB, voffB); PG8_STAGE(PG8_SB(0, 1), cB + hstep, voffB); PG8_STAGE(PG8_SA(0, 0), cA, voffA); PG8_STAGE(PG8_SA(0, 1), cA + hstep, voffA);
        if (wr == 1) PG8_BAR;
        PG8_WAIT_V(2); PG8_BAR;
        PG8_STAGE(PG8_SB(1, 0), cB + kstep, voffB); PG8_STAGE(PG8_SA(1, 0), cA + kstep, voffA); PG8_STAGE(PG8_SB(1, 1), cB + hstep + kstep, voffB);
        PG8_WAIT_V(6); PG8_BAR;
    } else {
        PG8_STAGE(PG8_SB(0, 0), cB, voffB); PG8_STAGE(PG8_SA(0, 0), cA, voffA); PG8_STAGE(PG8_SB(0, 1), cB + hstep, voffB); PG8_STAGE(PG8_SA(0, 1), cA + hstep, voffA);
        if (wr == 1) PG8_BAR;
        PG8_WAIT_V(4); PG8_BAR;
        PG8_STAGE(PG8_SB(1, 0), cB + kstep, voffB); PG8_STAGE(PG8_SA(1, 0), cA + kstep, voffA); PG8_STAGE(PG8_SB(1, 1), cB + hstep + kstep, voffB);
        PG8_WAIT_V(6); PG8_BAR;
    }
    for (;;) {
        const bool has_next = S.next(ui + 1, nxt);
        const char* nA = has_next ? (const char*)g.A + (size_t)nxt.pm * tstep : cA; const char* nB = has_next ? (const char*)g.Bt + (size_t)nxt.pn * tstep : cB;
        for (int t = 0; t < nt; t += 2) {
            const bool last = (t == nt - 2);
            const char* a1 = cA + (size_t)(t + 1) * kstep;
            const char* a2 = last ? nA : cA + (size_t)(t + 2) * kstep; const char* b2 = last ? nB : cB + (size_t)(t + 2) * kstep;
            const char* a3 = a2 + kstep; const char* b3 = b2 + kstep;
            if (last && has_next) S.a_ready(nxt);
            if constexpr (SP2) {
            PG8_LDB(B0, 0, 0); PG8_LDB(B1, 0, 1); PG8_SCHED; PG8_LDA(At, 0, 0); PG8_STAGE(PG8_SA(1, 1), a1 + hstep, voffA);
            PG8_WAIT_V(8); PG8_WAIT_L(0); PG8_BAR; PG8_MMA(0, 0, At, B0); PG8_MMA(0, 1, At, B1); PG8_BAR; PG8_SCHED;
            PG8_LDA(At, 0, 1); PG8_STAGE(PG8_SB(0, 0), b2, voffB); PG8_STAGE(PG8_SB(0, 1), b2 + hstep, voffB); PG8_STAGE(PG8_SA(0, 0), a2, voffA);
            PG8_WAIT_V(8); PG8_WAIT_L(0); PG8_BAR; PG8_MMA(1, 0, At, B0); PG8_MMA(1, 1, At, B1); PG8_BAR; PG8_SCHED;
            PG8_LDB(B0, 1, 0); PG8_LDB(B1, 1, 1); PG8_SCHED; PG8_LDA(At, 1, 0); PG8_STAGE(PG8_SA(0, 1), a2 + hstep, voffA);
            PG8_WAIT_V(8); PG8_WAIT_L(0); PG8_BAR; PG8_MMA(0, 0, At, B0); PG8_MMA(0, 1, At, B1); PG8_BAR; PG8_SCHED;
            PG8_LDA(At, 1, 1); PG8_STAGE(PG8_SB(1, 0), b3, voffB); PG8_STAGE(PG8_SB(1, 1), b3 + hstep, voffB); PG8_STAGE(PG8_SA(1, 0), a3, voffA);
            PG8_WAIT_V(8); PG8_WAIT_L(0); PG8_BAR; PG8_MMA(1, 0, At, B0); PG8_MMA(1, 1, At, B1); PG8_BAR; PG8_SCHED;
            } else {
            PG8_LDB(B0, 0, 0); PG8_SCHED; PG8_LDA(At, 0, 0); PG8_STAGE(PG8_SA(1, 1), a1 + hstep, voffA);
            PG8_WAIT_L(8); PG8_BAR; PG8_WAIT_L(0); PG8_MMA(0, 0, At, B0); PG8_BAR; PG8_SCHED;
            PG8_LDB(B1, 0, 1); PG8_STAGE(PG8_SB(0, 0), b2, voffB);
            PG8_BAR; PG8_WAIT_L(0); PG8_MMA(0, 1, At, B1); PG8_BAR;
            PG8_LDA(At, 0, 1); PG8_STAGE(PG8_SA(0, 0), a2, voffA);
            PG8_BAR; PG8_WAIT_L(0); PG8_MMA(1, 0, At, B0); PG8_BAR; PG8_SCHED;
            PG8_STAGE(PG8_SB(0, 1), b2 + hstep, voffB);
            PG8_WAIT_V(6); PG8_BAR; PG8_MMA(1, 1, At, B1); PG8_BAR;
            PG8_LDB(B0, 1, 0); PG8_SCHED; PG8_LDA(At, 1, 0); PG8_STAGE(PG8_SA(0, 1), a2 + hstep, voffA);
            PG8_WAIT_L(8); PG8_BAR; PG8_WAIT_L(0); PG8_MMA(0, 0, At, B0); PG8_BAR; PG8_SCHED;
            PG8_LDB(B1, 1, 1); PG8_STAGE(PG8_SB(1, 0), b3, voffB);
            PG8_BAR; PG8_WAIT_L(0); PG8_MMA(0, 1, At, B1); PG8_BAR;
            PG8_LDA(At, 1, 1); PG8_STAGE(PG8_SA(1, 0), a3, voffA);
            PG8_BAR; PG8_WAIT_L(0); PG8_MMA(1, 0, At, B0); PG8_BAR; PG8_SCHED;
            PG8_STAGE(PG8_SB(1, 1), b3 + hstep, voffB);
            PG8_WAIT_V(6); PG8_BAR; PG8_MMA(1, 1, At, B1); PG8_BAR;
            }
        }
        if constexpr (ALIGN_EPI) { if (wr == 0) PG8_BAR; }
        if constexpr (!Epi::AFTER_DRAIN) { E(acc, cur, wr, wc, fr, fq); S.done(cur); }
        if (!has_next) break;
#pragma unroll
        for (int a = 0; a < 2; ++a)
#pragma unroll
            for (int b = 0; b < 2; ++b)
#pragma unroll
                for (int m = 0; m < 4; ++m)
#pragma unroll
                    for (int n = 0; n < 2; ++n) acc[a][b][m][n] = (f32x4){0.f, 0.f, 0.f, 0.f};
        cur = nxt; cA = nA; cB = nB; ++ui;
        if constexpr (ALIGN_EPI) { if (wr == 1) PG8_BAR; }
    }
    PG8_WAIT_V(0);
    if constexpr (!ALIGN_EPI) { if (wr == 0) PG8_BAR; }
    PG8_BAR;
    if constexpr (Epi::AFTER_DRAIN) { E.fused(acc, cur, wr, wc, fr, fq, lds, wid, lane); S.done(cur); }
#undef PG8_SA
#undef PG8_SB
#undef PG8_STAGE
#undef PG8_LDA
#undef PG8_LDB
#undef PG8_MMA
#undef PG8_WAIT_V
#undef PG8_WAIT_L
#undef PG8_BAR
#undef PG8_SCHED
}
}

namespace att {
typedef __attribute__((address_space(3))) const char* lds_cptr;
typedef __attribute__((address_space(3))) char* lds_ptr;
typedef short s16x4 __attribute__((ext_vector_type(4)));
typedef short v4i16_t __attribute__((ext_vector_type(4)));
typedef unsigned u32x4 __attribute__((ext_vector_type(4)));
typedef float f32x2_t __attribute__((ext_vector_type(2))); typedef __bf16 bf16x2_t __attribute__((ext_vector_type(2)));
constexpr int SLOT = 16384, NSLOT = 3;
constexpr int LDS_K = 0, LDS_V = NSLOT * SLOT, LDS_WS = 2 * NSLOT * SLOT, LDS_STG = LDS_WS + 2048, LDS_END = LDS_STG + 4 * 8192;
constexpr float THR = 8.0f;
#define ATT_SBAR() __builtin_amdgcn_sched_barrier(0)
__device__ __forceinline__ int crow(int r, int hi) { return (r & 3) + 8 * (r >> 2) + 4 * hi; }
__device__ __forceinline__ void glds16(const void* gsrc, unsigned lds_dst) { unsigned keep;
    asm volatile("s_mov_b32 %0, m0\n\ts_mov_b32 m0, %2\n\ts_nop 0\n\tglobal_load_lds_dwordx4 %1, off\n\ts_mov_b32 m0, %0" : "=&s"(keep) : "v"(gsrc), "s"(lds_dst) : "memory"); }
__device__ __forceinline__ unsigned cvtpk_s(float lo, float hi) { f32x2_t v = {lo, hi}; bf16x2_t b = __builtin_convertvector(v, bf16x2_t); return __builtin_bit_cast(unsigned, b); }
__device__ __forceinline__ s16x4 vtr(lds_cptr p) { return __builtin_bit_cast(s16x4, __builtin_amdgcn_ds_read_tr16_b64_v4i16((__attribute__((address_space(3))) v4i16_t*)p)); }
#define ATT_MX3(a, b, c) __builtin_fmaxf(__builtin_fmaxf((a), (b)), (c))
__device__ __forceinline__ float rowmax(const f32x16& p0, const f32x16& p1) {
    float a = ATT_MX3(p0[0], p0[1], p1[0]), b = ATT_MX3(p0[2], p0[3], p1[1]); a = ATT_MX3(a, p1[2], p1[3]);
#pragma unroll
    for (int r = 4; r < 16; r += 4) { a = ATT_MX3(a, p0[r], p0[r + 1]); b = ATT_MX3(b, p0[r + 2], p0[r + 3]); a = ATT_MX3(a, p1[r], p1[r + 1]); b = ATT_MX3(b, p1[r + 2], p1[r + 3]); }
    float m = __builtin_fmaxf(a, b); auto rr = __builtin_amdgcn_permlane32_swap(__float_as_uint(m), __float_as_uint(m), false, false);
    return __builtin_fmaxf(__uint_as_float(rr[0]), __uint_as_float(rr[1])); }

struct Params { const bf16_t* QB; const bf16_t* KB; const bf16_t* VB; const bf16_t* GB; bf16_t* AT; const float* gsub; float lam, lam_init; };

__device__ __forceinline__ void attn_unit(char* shm, const Params& P, int hr0, int kr0, int NT) {
    int tid_ = threadIdx.x; asm volatile("" : "+v"(tid_));
    const int tid = tid_, lane = tid & 63, r32 = lane & 31, hi = lane >> 5; const int wid = __builtin_amdgcn_readfirstlane(tid >> 6);
    const int qblk = wid & 3, m = wid >> 2;
    const unsigned lds0 = (unsigned)(uintptr_t)shm;
    const lds_ptr shm3 = (lds_ptr)shm;
    __attribute__((address_space(3))) float* wsf = (__attribute__((address_space(3))) float*)(shm3 + LDS_WS) + wid * 64;
    const bf16_t* ksrc = P.KB + (size_t)(kr0 + lane) * 512 + wid * 8;
    const bf16_t* vsrc = P.VB + (size_t)(kr0 + 16 * (wid & 3) + (lane >> 2)) * 512 + (wid >> 2) * 32 + (lane & 3) * 8;
    const unsigned kdst = lds0 + LDS_K + wid * 1024, vdst = lds0 + LDS_V + (wid >> 2) * 4096 + (wid & 3) * 1024;
#define ATT_DMA(h_, t_, slotoff) do { const size_t go_ = (size_t)(t_) * (64 * 512) + (h_) * 128; \
        glds16(ksrc + go_, (unsigned)__builtin_amdgcn_readfirstlane(kdst + (slotoff))); glds16(ksrc + go_ + 64, (unsigned)__builtin_amdgcn_readfirstlane(kdst + (slotoff) + 8192)); \
        glds16(vsrc + go_, (unsigned)__builtin_amdgcn_readfirstlane(vdst + (slotoff))); glds16(vsrc + go_ + 64, (unsigned)__builtin_amdgcn_readfirstlane(vdst + (slotoff) + 8192)); } while (0)
#define ATT_WAIT_BAR(N) asm volatile("s_waitcnt vmcnt(" #N ") lgkmcnt(0)\n\ts_barrier" ::: "memory")
    const lds_cptr kp0 = (lds_cptr)shm3 + LDS_K + m * 8192 + hi * 1024 + r32 * 16;
    const lds_cptr vp0 = (lds_cptr)shm3 + LDS_V + ((lane >> 4) & 1) * 32 + (lane & 3) * 8 + (4 * hi + ((lane & 15) >> 2)) * 64;
    const int TT = 4 * NT;
    ATT_DMA(0, 0, 0);
    if (NT > 1) ATT_DMA(0, 1, SLOT); else ATT_DMA(1, 0, SLOT);
    int h = 0, t = 0, sl_cur = 0, sl_nn = 2 * SLOT;
    int h2 = (NT > 2) ? 0 : ((NT == 2) ? 1 : 2), t2 = (NT > 2) ? 2 : 0;
    bf16x8 qr[4]; f32x16 o[4]; float mhat = 0.f, l_reg = 0.f;
    for (int T = 0; T < TT; ++T) {
        if (T == 0) ATT_WAIT_BAR(0); else if (T + 1 < TT) ATT_WAIT_BAR(4); else ATT_WAIT_BAR(0);
        if (T + 2 < TT) ATT_DMA(h2, t2, sl_nn);
        if (t == 0) {
            const bf16_t* qp = P.QB + (size_t)(hr0 + 32 * qblk + r32) * 512 + h * 128 + m * 64 + hi * 8;
#pragma unroll
            for (int d0 = 0; d0 < 4; ++d0) qr[d0] = *(const bf16x8*)(qp + d0 * 16);
#pragma unroll
            for (int d = 0; d < 4; ++d) o[d] = f32x16{};
            mhat = 0.f; l_reg = 0.f;
        }
        f32x16 negm;
#pragma unroll
        for (int r = 0; r < 16; ++r) negm[r] = -mhat;
        f32x16 p0, p1;
        { const lds_cptr kp = kp0 + sl_cur;
#pragma unroll
          for (int d0 = 0; d0 < 4; ++d0) {
              const bf16x8 k0 = *(const __attribute__((address_space(3))) bf16x8*)(kp + d0 * 2048);
              const bf16x8 k1 = *(const __attribute__((address_space(3))) bf16x8*)(kp + d0 * 2048 + 512);
              if (d0 == 0) { p0 = __builtin_amdgcn_mfma_f32_32x32x16_bf16(k0, qr[0], negm, 0, 0, 0); p1 = __builtin_amdgcn_mfma_f32_32x32x16_bf16(k1, qr[0], negm, 0, 0, 0); }
              else { p0 = __builtin_amdgcn_mfma_f32_32x32x16_bf16(k0, qr[d0], p0, 0, 0, 0); p1 = __builtin_amdgcn_mfma_f32_32x32x16_bf16(k1, qr[d0], p1, 0, 0, 0); } } }
        const float rm = rowmax(p0, p1);
        const bool first = (t == 0);
        if (first || __any(rm > THR)) {
            const float dl = first ? rm : __builtin_fmaxf(rm, 0.f); mhat += dl;
#pragma unroll
            for (int r = 0; r < 16; ++r) { p0[r] -= dl; p1[r] -= dl; }
            if (!first) {
                const float f = __builtin_amdgcn_exp2f(-dl); l_reg *= f; if (hi == 0) wsf[r32] = f;
                asm volatile("s_waitcnt lgkmcnt(0)" ::: "memory");
#pragma unroll
                for (int d = 0; d < 4; ++d)
#pragma unroll
                    for (int r = 0; r < 16; ++r) o[d][r] *= wsf[crow(r, hi)];
            }
        }
        float sacc = 0.f;
#pragma unroll
        for (int r = 0; r < 16; ++r) { p0[r] = __builtin_amdgcn_exp2f(p0[r]); p1[r] = __builtin_amdgcn_exp2f(p1[r]); sacc += p0[r] + p1[r]; }
        l_reg += sacc;
        u32x4 pw0, pw1, pw2, pw3;
        pw0 = (u32x4){cvtpk_s(p0[0], p0[1]), cvtpk_s(p0[2], p0[3]), cvtpk_s(p0[4], p0[5]), cvtpk_s(p0[6], p0[7])};
        pw1 = (u32x4){cvtpk_s(p0[8], p0[9]), cvtpk_s(p0[10], p0[11]), cvtpk_s(p0[12], p0[13]), cvtpk_s(p0[14], p0[15])};
        pw2 = (u32x4){cvtpk_s(p1[0], p1[1]), cvtpk_s(p1[2], p1[3]), cvtpk_s(p1[4], p1[5]), cvtpk_s(p1[6], p1[7])};
        pw3 = (u32x4){cvtpk_s(p1[8], p1[9]), cvtpk_s(p1[10], p1[11]), cvtpk_s(p1[12], p1[13]), cvtpk_s(p1[14], p1[15])};
        { const lds_cptr vp = vp0 + sl_cur;
#pragma unroll
          for (int db = 0; db < 4; ++db) {
#pragma unroll
              for (int ks = 0; ks < 4; ++ks) {
                  const s16x4 lo = vtr(vp + db * 4096 + ks * 1024), hh = vtr(vp + db * 4096 + ks * 1024 + 512);
                  const bf16x8 vf = (bf16x8){lo[0], lo[1], lo[2], lo[3], hh[0], hh[1], hh[2], hh[3]};
                  const bf16x8 pa = __builtin_bit_cast(bf16x8, ks == 0 ? pw0 : ks == 1 ? pw1 : ks == 2 ? pw2 : pw3);
                  o[db] = __builtin_amdgcn_mfma_f32_32x32x16_bf16(pa, vf, o[db], 0, 0, 0); } } }
        if (t == NT - 1) {
            { auto rr = __builtin_amdgcn_permlane32_swap(__float_as_uint(l_reg), __float_as_uint(l_reg), false, false); l_reg = __uint_as_float(rr[0]) + __uint_as_float(rr[1]); }
            if (hi == 0) wsf[32 + r32] = l_reg;
            asm volatile("s_waitcnt lgkmcnt(0)" ::: "memory");
            float rli[16];
#pragma unroll
            for (int r = 0; r < 16; ++r) rli[r] = __builtin_amdgcn_rcpf(wsf[32 + crow(r, hi)]) * (m == 1 ? P.lam : 1.0f);
#pragma unroll
            for (int d = 0; d < 4; ++d)
#pragma unroll
                for (int r = 0; r < 16; ++r) o[d][r] *= rli[r];
            __attribute__((address_space(3))) unsigned* stg = (__attribute__((address_space(3))) unsigned*)(shm3 + LDS_STG + qblk * 8192) + lane;
            if (m == 1) {
#pragma unroll
                for (int d = 0; d < 4; ++d)
#pragma unroll
                    for (int r2 = 0; r2 < 8; ++r2) stg[(d * 8 + r2) * 64] = cvtpk_s(o[d][2 * r2], o[d][2 * r2 + 1]);
            }
            asm volatile("s_waitcnt lgkmcnt(0)\n\ts_barrier" ::: "memory");
            if (m == 0) {
                float ss[16];
#pragma unroll
                for (int r = 0; r < 16; ++r) ss[r] = 0.f;
#pragma unroll
                for (int d = 0; d < 4; ++d)
#pragma unroll
                    for (int r2 = 0; r2 < 8; ++r2) { const unsigned w = stg[(d * 8 + r2) * 64];
                        o[d][2 * r2] -= __uint_as_float(w << 16); o[d][2 * r2 + 1] -= __uint_as_float(w & 0xffff0000u);
                        ss[2 * r2] += o[d][2 * r2] * o[d][2 * r2]; ss[2 * r2 + 1] += o[d][2 * r2 + 1] * o[d][2 * r2 + 1]; }
#pragma unroll
                for (int r = 0; r < 16; ++r) { float v = ss[r]; v += __shfl_xor(v, 1); v += __shfl_xor(v, 2); v += __shfl_xor(v, 4); v += __shfl_xor(v, 8); v += __shfl_xor(v, 16);
                    ss[r] = (1.0f / sqrtf(v * (1.f / 128.f) + EPS)) * (1.f - P.lam_init); }
                __attribute__((address_space(3))) bf16_t* tl = (__attribute__((address_space(3))) bf16_t*)(shm3 + LDS_STG + qblk * 8192);
                asm volatile("s_waitcnt lgkmcnt(0)" ::: "memory");
#pragma unroll
                for (int d = 0; d < 4; ++d) { const float gs = P.gsub[32 * d + r32];
#pragma unroll
                    for (int r = 0; r < 16; ++r) tl[crow(r, hi) * 128 + 32 * d + r32] = f2bf(o[d][r] * ss[r] * gs); }
                asm volatile("s_waitcnt lgkmcnt(0)" ::: "memory");
                { const int row = lane >> 1, half = lane & 1; const size_t grow = (size_t)(hr0 + 32 * qblk + row);
                  const bf16_t* gp = P.GB + grow * GW + h * 128 + half * 64; bf16_t* ap = P.AT + grow * DM + h * 128 + half * 64;
                  const __attribute__((address_space(3))) u32x4* tp = (const __attribute__((address_space(3))) u32x4*)(tl + row * 128 + half * 64);
                  u32x4 gv[8];
#pragma unroll
                  for (int c = 0; c < 8; ++c) gv[c] = *(const u32x4*)(gp + c * 8);
#pragma unroll
                  for (int c = 0; c < 8; ++c) { const u32x4 v = tp[c]; const u32x4 g = gv[c]; u32x4 w;
#pragma unroll
                      for (int e = 0; e < 4; ++e) { const float a0 = __uint_as_float(v[e] << 16) * silu_f(__uint_as_float(g[e] << 16)), a1 = __uint_as_float(v[e] & 0xffff0000u) * silu_f(__uint_as_float(g[e] & 0xffff0000u));
                          w[e] = cvtpk_s(a0, a1); }
                      *(u32x4*)(ap + c * 8) = w; } }
            }
        }
        if (++t == NT) { t = 0; ++h; }
        if (++t2 == NT) { t2 = 0; ++h2; }
        sl_cur = (sl_cur == 2 * SLOT) ? 0 : sl_cur + SLOT; sl_nn = (sl_nn == 2 * SLOT) ? 0 : sl_nn + SLOT;
    }
    asm volatile("s_waitcnt vmcnt(0) lgkmcnt(0)\n\ts_barrier" ::: "memory");
#undef ATT_DMA
#undef ATT_WAIT_BAR
}
}

namespace tail {
typedef __attribute__((address_space(3))) char* lds_ptr;
typedef unsigned u32x4 __attribute__((ext_vector_type(4)));
__device__ __forceinline__ void unpack8(const u32x4 v, float (&f)[8]) {
#pragma unroll
    for (int e = 0; e < 4; ++e) { f[2 * e] = __uint_as_float(v[e] << 16); f[2 * e + 1] = __uint_as_float(v[e] & 0xffff0000u); } }
__device__ __forceinline__ u32x4 pack8(const float (&f)[8]) { u32x4 w;
#pragma unroll
    for (int e = 0; e < 4; ++e) w[e] = att::cvtpk_s(f[2 * e], f[2 * e + 1]);
    return w; }

struct Unit { int hr0;
              int t0, len;
              int mrow;
              const float* xin; float* xout; };

__device__ __forceinline__ void conv_b(const bf16_t* __restrict__ GB, bf16_t* __restrict__ AT, const float* wsh, const Unit& U, int tid) {
    const int cv = tid & 31, tg = tid >> 5, c0 = 8 * cv;
    float w[3][8];
#pragma unroll
    for (int j = 0; j < 3; ++j)
#pragma unroll
        for (int e = 0; e < 8; ++e) w[j][e] = wsh[j * 256 + c0 + e];
    float pm[8], pc[8], pn[8];
    auto prod = [&](int tl, float (&p)[8]) {
        const int t = U.t0 + tl;
        if (t >= 0 && t < U.len) { const bf16_t* g = GB + (size_t)(U.hr0 + tl) * GW; float a[8], b[8]; unpack8(*(const u32x4*)(g + 768 + c0), a); unpack8(*(const u32x4*)(g + 1024 + c0), b);
#pragma unroll
            for (int e = 0; e < 8; ++e) p[e] = a[e] * b[e]; }
        else {
#pragma unroll
            for (int e = 0; e < 8; ++e) p[e] = 0.f; } };
    prod(8 * tg - 1, pm); prod(8 * tg, pc);
#pragma unroll
    for (int i = 0; i < 8; ++i) {
        const int tl = 8 * tg + i; prod(tl + 1, pn);
        const bf16_t* g = GB + (size_t)(U.hr0 + tl) * GW; float bb[8], gb[8], y[8]; unpack8(*(const u32x4*)(g + 512 + c0), bb); unpack8(*(const u32x4*)(g + 1280 + c0), gb);
#pragma unroll
        for (int e = 0; e < 8; ++e) { const float acc = w[0][e] * pm[e] + w[1][e] * pc[e] + w[2][e] * pn[e]; y[e] = bb[e] * acc * silu_f(gb[e]); }
        *(u32x4*)(AT + (size_t)(U.hr0 + tl) * DM + 512 + c0) = pack8(y);
#pragma unroll
        for (int e = 0; e < 8; ++e) { pm[e] = pc[e]; pc[e] = pn[e]; }
    }
}

__device__ __forceinline__ void conv_c(char* shm, const bf16_t* __restrict__ GB, bf16_t* __restrict__ AT, const float* wcf, const float* bcf, const float* gln, const float* bln, const Unit& U, int tid) {
    const lds_ptr shm3 = (lds_ptr)shm;
    const int cvh = tid & 15, tg = tid >> 4;
    float v[2][4][8];
#pragma unroll
    for (int hf = 0; hf < 2; ++hf) {
        for (int item = tid; item < 160 * 16; item += 512) {
            const int i = item >> 4, cq = item & 15, t = U.t0 - 15 + i; float u[8];
            if (t >= 0 && t < U.len) { const bf16_t* g = GB + (size_t)(U.hr0 - 15 + i) * GW + 128 * hf + 8 * cq; float a[8], b[8]; unpack8(*(const u32x4*)(g + 1536), a); unpack8(*(const u32x4*)(g + 1792), b);
#pragma unroll
                for (int e = 0; e < 8; ++e) u[e] = a[e] * sigmoid_f(b[e]); }
            else {
#pragma unroll
                for (int e = 0; e < 8; ++e) u[e] = 0.f; }
            __attribute__((address_space(3))) f32x4* d = (__attribute__((address_space(3))) f32x4*)(shm3 + (size_t)(i * 128 + 8 * cq) * 4);
            d[0] = (f32x4){u[0], u[1], u[2], u[3]}; d[1] = (f32x4){u[4], u[5], u[6], u[7]};
        }
        __syncthreads();
        const int c0 = 128 * hf + 8 * cvh;
#pragma unroll
        for (int tt = 0; tt < 4; ++tt)
#pragma unroll
            for (int e = 0; e < 8; ++e) v[hf][tt][e] = bcf[c0 + e];
#pragma unroll 1
        for (int jb = 0; jb < 8; ++jb) {
            float ur[7][8];
#pragma unroll
            for (int q = 0; q < 7; ++q) { const __attribute__((address_space(3))) f32x4* s = (const __attribute__((address_space(3))) f32x4*)(shm3 + (size_t)((4 * tg + 4 * jb + q) * 128 + 8 * cvh) * 4);
                const f32x4 u0 = s[0], u1 = s[1]; ur[q][0] = u0[0]; ur[q][1] = u0[1]; ur[q][2] = u0[2]; ur[q][3] = u0[3]; ur[q][4] = u1[0]; ur[q][5] = u1[1]; ur[q][6] = u1[2]; ur[q][7] = u1[3]; }
#pragma unroll
            for (int jj = 0; jj < 4; ++jj) { const int j = 4 * jb + jj; const int jc = j < 31 ? j : 30; const float wm = j < 31 ? 1.f : 0.f;
                const f32x4 w0 = *(const f32x4*)(wcf + jc * 256 + c0) * wm, w1 = *(const f32x4*)(wcf + jc * 256 + c0 + 4) * wm;
#pragma unroll
                for (int tt = 0; tt < 4; ++tt) {
                    v[hf][tt][0] += w0[0] * ur[tt + jj][0]; v[hf][tt][1] += w0[1] * ur[tt + jj][1]; v[hf][tt][2] += w0[2] * ur[tt + jj][2]; v[hf][tt][3] += w0[3] * ur[tt + jj][3];
                    v[hf][tt][4] += w1[0] * ur[tt + jj][4]; v[hf][tt][5] += w1[1] * ur[tt + jj][5]; v[hf][tt][6] += w1[2] * ur[tt + jj][6]; v[hf][tt][7] += w1[3] * ur[tt + jj][7]; } }
        }
        __syncthreads();
    }
#pragma unroll
    for (int tt = 0; tt < 4; ++tt) {
        float s1 = 0.f;
#pragma unroll
        for (int hf = 0; hf < 2; ++hf)
#pragma unroll
            for (int e = 0; e < 8; ++e) s1 += v[hf][tt][e];
        s1 += __shfl_xor(s1, 1); s1 += __shfl_xor(s1, 2); s1 += __shfl_xor(s1, 4); s1 += __shfl_xor(s1, 8);
        const float mean = s1 * (1.f / 256.f); float s2 = 0.f;
#pragma unroll
        for (int hf = 0; hf < 2; ++hf)
#pragma unroll
            for (int e = 0; e < 8; ++e) { const float d = v[hf][tt][e] - mean; s2 += d * d; }
        s2 += __shfl_xor(s2, 1); s2 += __shfl_xor(s2, 2); s2 += __shfl_xor(s2, 4); s2 += __shfl_xor(s2, 8);
        const float rstd = 1.0f / sqrtf(s2 * (1.f / 256.f) + EPS);
        const int tl = 4 * tg + tt;
#pragma unroll
        for (int hf = 0; hf < 2; ++hf) { const int c0 = 128 * hf + 8 * cvh; float gc[8], y[8]; unpack8(*(const u32x4*)(GB + (size_t)(U.hr0 + tl) * GW + 2048 + c0), gc);
#pragma unroll
            for (int e = 0; e < 8; ++e) { const float z = (v[hf][tt][e] - mean) * rstd * gln[c0 + e] + bln[c0 + e]; y[e] = silu_f(z) * silu_f(gc[e]); }
            *(u32x4*)(AT + (size_t)(U.hr0 + tl) * DM + 768 + c0) = pack8(y); }
    }
}

constexpr int OP_BUF = 49152, OP_A = 0, OP_B = 16384;
__device__ __forceinline__ void outproj(char* shm, const bf16_t* A, const bf16_t* WT, const Unit& U, const float* gt, int tid) {
    const int lane = tid & 63, r32 = lane & 31, hi = lane >> 5; const int wid = __builtin_amdgcn_readfirstlane(tid >> 6), wr = wid >> 2, wc = wid & 3;
    const unsigned lds0 = (unsigned)(uintptr_t)shm; const lds_ptr shm3 = (lds_ptr)shm;
    const int rr = lane >> 3, cs = (lane & 7) ^ rr;
    const bf16_t* asrc0 = A + (size_t)(8 * wid + rr) * DM + 8 * cs;
    const unsigned adst0 = lds0 + OP_A + wid * 1024;
    const bf16_t* bsrc0 = WT + (size_t)(8 * wid + rr) * DM + 8 * cs;
    const unsigned bdst0 = lds0 + OP_B + wid * 1024;
#define OP_STAGE(s_, bo_) do { const int ch_ = (s_) >> 4, kt_ = (s_) & 15; \
        att::glds16(asrc0 + kt_ * 64, (unsigned)__builtin_amdgcn_readfirstlane(adst0 + (bo_))); att::glds16(asrc0 + (size_t)64 * DM + kt_ * 64, (unsigned)__builtin_amdgcn_readfirstlane(adst0 + (bo_) + 8192)); \
        _Pragma("unroll") for (int i_ = 0; i_ < 4; ++i_) att::glds16(bsrc0 + (size_t)(ch_ * 256 + 64 * i_) * DM + kt_ * 64, (unsigned)__builtin_amdgcn_readfirstlane(bdst0 + (bo_) + i_ * 8192)); } while (0)
    f32x16 acc[2][2];
    OP_STAGE(0, 0); OP_STAGE(1, OP_BUF);
    unsigned bo_cur = 0, bo_nn = 2 * OP_BUF;
    int aoff[4], boff[4];
#pragma unroll
    for (int ks = 0; ks < 4; ++ks) { const int sw = ((2 * ks + hi) ^ (r32 & 7)) << 4; aoff[ks] = OP_A + (64 * wr + r32) * 128 + sw; boff[ks] = OP_B + (64 * wc + r32) * 128 + sw; }
    for (int s = 0; s < 64; ++s) {
        if (s + 1 < 64) asm volatile("s_waitcnt vmcnt(6) lgkmcnt(0)\n\ts_barrier" ::: "memory"); else asm volatile("s_waitcnt vmcnt(0) lgkmcnt(0)\n\ts_barrier" ::: "memory");
        if (s + 2 < 64) OP_STAGE(s + 2, bo_nn);
        if ((s & 15) == 0) {
#pragma unroll
            for (int a = 0; a < 2; ++a)
#pragma unroll
                for (int b = 0; b < 2; ++b) acc[a][b] = f32x16{};
        }
        const lds_ptr sb = shm3 + bo_cur;
#pragma unroll
        for (int ks = 0; ks < 4; ++ks) {
            bf16x8 af[2], bfr[2];
#pragma unroll
            for (int mt = 0; mt < 2; ++mt) af[mt] = *(const __attribute__((address_space(3))) bf16x8*)(sb + aoff[ks] + mt * 4096);
#pragma unroll
            for (int nt = 0; nt < 2; ++nt) bfr[nt] = *(const __attribute__((address_space(3))) bf16x8*)(sb + boff[ks] + nt * 4096);
#pragma unroll
            for (int mt = 0; mt < 2; ++mt)
#pragma unroll
                for (int nt = 0; nt < 2; ++nt) acc[mt][nt] = __builtin_amdgcn_mfma_f32_32x32x16_bf16(af[mt], bfr[nt], acc[mt][nt], 0, 0, 0);
        }
        if ((s & 15) == 15) {
            const int ch = s >> 4;
            const unsigned loff = (unsigned)(4 * hi * DM + r32);
#pragma unroll
            for (int nt = 0; nt < 2; ++nt) { const int nu = 256 * ch + 64 * wc + 32 * nt; const float g = gt[nu + r32];
                float xv[2][16];
#pragma unroll
                for (int mt = 0; mt < 2; ++mt)
#pragma unroll
                    for (int r = 0; r < 16; ++r) { const float* pu = U.xin + (size_t)((64 * wr + 32 * mt + (r & 3) + 8 * (r >> 2)) * DM + nu); xv[mt][r] = pu[loff]; }
#pragma unroll
                for (int mt = 0; mt < 2; ++mt)
#pragma unroll
                    for (int r = 0; r < 16; ++r) { float* pu = U.xout + (size_t)((64 * wr + 32 * mt + (r & 3) + 8 * (r >> 2)) * DM + nu); pu[loff] = xv[mt][r] + g * acc[mt][nt][r]; }
                asm volatile("" ::: "memory"); }
        }
        bo_cur = (bo_cur == 2 * OP_BUF) ? 0 : bo_cur + OP_BUF; bo_nn = (bo_nn == 2 * OP_BUF) ? 0 : bo_nn + OP_BUF;
    }
#undef OP_STAGE
}

__device__ __forceinline__ void rowpass(const Unit& U, bool last, const float* g, const float* modn, bf16_t* H, int tid) {
    const int lane = tid & 63; const int wid = __builtin_amdgcn_readfirstlane(tid >> 6);
    const float* sh = modn + (size_t)U.mrow * 3072; const float* sc = sh + 1024;
#pragma unroll 1
    for (int rb = 0; rb < 4; ++rb) {
        f32x4 v[4][4]; float rstd[4];
#pragma unroll
        for (int q = 0; q < 4; ++q) { const f32x4* xr = (const f32x4*)(U.xout + (size_t)(wid * 16 + rb * 4 + q) * DM) + lane;
#pragma unroll
            for (int j = 0; j < 4; ++j) v[q][j] = xr[64 * j]; }
#pragma unroll
        for (int q = 0; q < 4; ++q) { float ss = 0.f;
#pragma unroll
            for (int j = 0; j < 4; ++j) ss += (v[q][j].x * v[q][j].x + v[q][j].y * v[q][j].y) + (v[q][j].z * v[q][j].z + v[q][j].w * v[q][j].w);
            rstd[q] = 1.0f / sqrtf(wave_sum(ss) * (1.f / DM) + EPS); }
#pragma unroll
        for (int q = 0; q < 4; ++q) { const int row = wid * 16 + rb * 4 + q;
            if (last) { f32x4* xr = (f32x4*)(U.xout + (size_t)row * DM) + lane;
#pragma unroll
                for (int j = 0; j < 4; ++j) { const f32x4 gg = *(const f32x4*)(g + 4 * lane + 256 * j); f32x4 o = v[q][j] * rstd[q]; o.x *= gg.x; o.y *= gg.y; o.z *= gg.z; o.w *= gg.w; xr[64 * j] = o; }
            } else { bf16_t* o = H + (size_t)(U.hr0 + row) * DM;
#pragma unroll
                for (int j = 0; j < 4; ++j) { const int k = 4 * lane + 256 * j;
                    const f32x4 gg = *(const f32x4*)(g + k), s1 = *(const f32x4*)(sc + k), s0 = *(const f32x4*)(sh + k);
                    ushort4 w; w.x = f2bf(v[q][j].x * rstd[q] * gg.x * (1.f + s1.x) + s0.x); w.y = f2bf(v[q][j].y * rstd[q] * gg.y * (1.f + s1.y) + s0.y);
                    w.z = f2bf(v[q][j].z * rstd[q] * gg.z * (1.f + s1.z) + s0.z); w.w = f2bf(v[q][j].w * rstd[q] * gg.w * (1.f + s1.w) + s0.w);
                    *(ushort4*)(o + k) = w; } }
        }
    }
}
}

namespace pro {
typedef __attribute__((address_space(3))) float* lds_f;
__device__ __forceinline__ void transpose_item(const float* W, int K, int N, bf16_t* WT, lds_f scr, int item, int lane) {
    const int nblk = N / 32, kb = item / nblk, nb = item % nblk, k0 = 64 * kb, n0 = 32 * nb;
#pragma unroll 8
    for (int i = 0; i < 32; ++i) { const int kk = 2 * i + (lane >> 5); scr[kk * 33 + (lane & 31)] = W[(size_t)(k0 + kk) * N + n0 + (lane & 31)]; }
    asm volatile("s_waitcnt lgkmcnt(0)" ::: "memory");
    const int c = lane & 7;
#pragma unroll
    for (int j = 0; j < 4; ++j) { const int n = (lane >> 3) + 8 * j; const lds_f s = scr + (8 * c) * 33 + n;
        att::u32x4 o; o.x = att::cvtpk_s(s[0 * 33], s[1 * 33]); o.y = att::cvtpk_s(s[2 * 33], s[3 * 33]); o.z = att::cvtpk_s(s[4 * 33], s[5 * 33]); o.w = att::cvtpk_s(s[6 * 33], s[7 * 33]);
        *(att::u32x4*)(WT + (size_t)(n0 + n) * K + k0 + 8 * c) = o; }
    asm volatile("s_waitcnt lgkmcnt(0)" ::: "memory");
}
__device__ __forceinline__ void p0(char* shm, const float* const* in, unsigned char* ws, int tid, int nblocks) {
    const int lane = tid & 63; const int wave = __builtin_amdgcn_readfirstlane(tid >> 6);
    const __attribute__((address_space(3))) char* shm3c = (const __attribute__((address_space(3))) char*)shm; (void)shm3c;
    __attribute__((address_space(3))) char* shm3 = (__attribute__((address_space(3))) char*)shm;
    if (blockIdx.x < 96) {
        lds_f s = (lds_f)shm3;
        lds_f red = (lds_f)(shm3 + 36864);
        const float* c = in[1]; const float* cctx = in[3];
        for (int i = tid; i < 9 * 1024; i += 512) { const int r = i >> 10, k = i & 1023; const float v = r < 8 ? c[r * 1024 + k] : cctx[k]; s[i] = silu_f(v); }
        __syncthreads();
        const int l = blockIdx.x / 48, n = 64 * (blockIdx.x % 48) + (tid & 63), kq = tid >> 6;
        float acc[9];
#pragma unroll
        for (int r = 0; r < 9; ++r) acc[r] = 0.f;
        const float* w = in[4] + (size_t)l * 1024 * 3072 + n;
#pragma unroll 4
        for (int k = kq * 128; k < kq * 128 + 128; ++k) { const float wv = w[(size_t)k * 3072];
#pragma unroll
            for (int r = 0; r < 9; ++r) acc[r] += s[r * 1024 + k] * wv; }
#pragma unroll
        for (int r = 0; r < 9; ++r) red[(kq * 9 + r) * 64 + (tid & 63)] = acc[r];
        __syncthreads();
        if (tid < 64) {
            float* MOD = (float*)(ws + WS_MOD);
#pragma unroll
            for (int r = 0; r < 9; ++r) { float v = 0.f;
#pragma unroll
                for (int q = 0; q < 8; ++q) v += red[(q * 9 + r) * 64 + tid];
                MOD[((size_t)l * 9 + r) * 3072 + n] = v + in[5][l * 3072 + n]; }
        }
        __syncthreads();
    }
    if ((int)blockIdx.x == nblocks - 1) {
        for (int i = tid; i < 1024; i += 512) {
            const int pos = i >> 4, f = i & 15;
            double inv = 1.0; for (int j = 0; j < f; ++j) inv *= 0.5623413251903491;
            const double ang = (double)pos * inv, hp = 1.5707963267948966;
            const double kq = __builtin_floor(ang / hp + 0.5); const double r = ang - kq * hp - kq * 6.123233995736766e-17;
            const double r2 = r * r;
            const double sn = r * (1.0 + r2 * (-1.0 / 6 + r2 * (1.0 / 120 + r2 * (-1.0 / 5040 + r2 * (1.0 / 362880 + r2 * (-1.0 / 39916800 + r2 * (1.0 / 6227020800.0 + r2 * (-1.0 / 1307674368000.0))))))));
            const double cs = 1.0 + r2 * (-0.5 + r2 * (1.0 / 24 + r2 * (-1.0 / 720 + r2 * (1.0 / 40320 + r2 * (-1.0 / 3628800 + r2 * (1.0 / 479001600.0 + r2 * (-1.0 / 87178291200.0 + r2 * (1.0 / 20922789888000.0))))))));
            const int q = ((int)kq) & 3; double co, si;
            if (q == 0) { co = cs; si = sn; } else if (q == 1) { co = -sn; si = cs; } else if (q == 2) { co = -cs; si = -sn; } else { co = sn; si = -cs; }
            ((float2*)(ws + WS_ROPE))[i] = make_float2((float)co, (float)si);
        }
    }
    lds_f scr = (lds_f)(shm3 + 65536 + wave * 8448);
    constexpr int I_IN = (DM / 64) * (DIN / 32), I_OUT = (DM / 64) * (DM / 32), I_L = I_IN + I_OUT;
    const int gw = (int)blockIdx.x * 8 + wave, NGW = nblocks * 8;
    for (int it = gw; it < NL * I_L; it += NGW) {
        const int l = it / I_L, r = it % I_L;
        if (r < I_IN) transpose_item(in[7] + (size_t)l * DM * DIN, DM, DIN, (bf16_t*)(ws + WS_WIN) + (size_t)l * DIN * DM, scr, r, lane);
        else transpose_item(in[18] + (size_t)l * DM * DM, DM, DM, (bf16_t*)(ws + WS_WOUT) + (size_t)l * DM * DM, scr, r - I_IN, lane);
    }
}
__device__ __forceinline__ void p1(const float* const* in, unsigned char* ws, int tid, int nblocks) {
    const int lane = tid & 63; const int wave = __builtin_amdgcn_readfirstlane(tid >> 6);
    const float* MOD0 = (const float*)(ws + WS_MOD); const float* g = in[6]; bf16_t* H = (bf16_t*)(ws + WS_H);
    for (int hr = (int)blockIdx.x * 8 + wave; hr < MROWS; hr += nblocks * 8) {
        const bool lat = hr < NLAT; const float* src = lat ? in[0] + (size_t)hr * DM : in[2] + (size_t)(hr - NLAT) * DM; const int mrow = lat ? (hr >> 12) : 8;
        const f32x4* xr = (const f32x4*)src + lane;
        f32x4 v[4]; float ss = 0.f;
#pragma unroll
        for (int j = 0; j < 4; ++j) { v[j] = xr[64 * j]; ss += (v[j].x * v[j].x + v[j].y * v[j].y) + (v[j].z * v[j].z + v[j].w * v[j].w); }
        const float rstd = 1.0f / sqrtf(wave_sum(ss) * (1.f / DM) + EPS);
        const float* sh = MOD0 + (size_t)mrow * 3072; const float* sc = sh + 1024; bf16_t* o = H + (size_t)hr * DM;
#pragma unroll
        for (int j = 0; j < 4; ++j) { const int k = 4 * lane + 256 * j;
            const f32x4 gg = *(const f32x4*)(g + k), s1 = *(const f32x4*)(sc + k), s0 = *(const f32x4*)(sh + k);
            ushort4 w; w.x = f2bf(v[j].x * rstd * gg.x * (1.f + s1.x) + s0.x); w.y = f2bf(v[j].y * rstd * gg.y * (1.f + s1.y) + s0.y);
            w.z = f2bf(v[j].z * rstd * gg.z * (1.f + s1.z) + s0.z); w.w = f2bf(v[j].w * rstd * gg.w * (1.f + s1.w) + s0.w);
            *(ushort4*)(o + k) = w; }
    }
}
}

struct EpiInProj {
    static constexpr bool PERM = true, AFTER_DRAIN = false;
    bf16_t *QB, *KB, *VB, *GB; const float2* rope;
    __device__ __forceinline__ void operator()(const pg8::f32x4 (&acc)[2][2][4][2], const pg8::Unit& u, int wr, int wc, int fr, int fq) const {
        const bool lat = u.pm < 128; const int b = lat ? (u.pm >> 4) : (u.pm - 128); const int t0 = lat ? (u.pm & 15) * 256 : 0;
        const int hr0 = u.pm * 256, kr0 = b * KEYS + (lat ? CTX : 0) + t0, pn = u.pn;
#pragma unroll
        for (int ai = 0; ai < 2; ++ai)
#pragma unroll
            for (int m = 0; m < 4; ++m) {
                const int rl = 128 * ai + 64 * wr + 16 * m + fr, t = t0 + rl;
#pragma unroll
                for (int bj = 0; bj < 2; ++bj) {
                    const int nl = 128 * bj + 32 * wc + 8 * fq;
                    pg8::f32x4 v0 = acc[ai][bj][m][0], v1 = acc[ai][bj][m][1];
                    bf16_t* dst;
                    if (pn < 4) {
                        if (lat) {
                            const int i0 = (nl & 63) >> 1; const int pos = (i0 < 16) ? (t >> 6) : (t & 63);
                            const pg8::f32x4* rp = (const pg8::f32x4*)(rope + pos * 16 + (i0 & 15)); const pg8::f32x4 c0 = rp[0], c1 = rp[1];
                            pg8::f32x4 o0, o1;
                            o0[0] = v0[0] * c0[0] - v0[1] * c0[1]; o0[1] = v0[0] * c0[1] + v0[1] * c0[0]; o0[2] = v0[2] * c0[2] - v0[3] * c0[3]; o0[3] = v0[2] * c0[3] + v0[3] * c0[2];
                            o1[0] = v1[0] * c1[0] - v1[1] * c1[1]; o1[1] = v1[0] * c1[1] + v1[1] * c1[0]; o1[2] = v1[2] * c1[2] - v1[3] * c1[3]; o1[3] = v1[2] * c1[3] + v1[3] * c1[2];
                            v0 = o0; v1 = o1;
                        }
                        if (pn < 2) { v0 = v0 * C2; v1 = v1 * C2; dst = QB + (size_t)(hr0 + rl) * 512 + pn * 256 + nl; }
                        else dst = KB + (size_t)(kr0 + rl) * 512 + (pn - 2) * 256 + nl;
                    } else if (pn < 6) dst = VB + (size_t)(kr0 + rl) * 512 + (pn - 4) * 256 + nl;
                    else dst = GB + (size_t)(hr0 + rl) * GW + (pn - 6) * 256 + nl;
                    pg8::u32x4 w; w.x = pg8::cvt_pk_bf16(v0[0], v0[1]); w.y = pg8::cvt_pk_bf16(v0[2], v0[3]); w.z = pg8::cvt_pk_bf16(v1[0], v1[1]); w.w = pg8::cvt_pk_bf16(v1[2], v1[3]);
                    *(pg8::u32x4*)dst = w;
                }
            }
    }
};
struct InSched {
    pg8::StaticOrder so; int G, c, nctx_cols, ctx_col0;
    __device__ void init(int G_, int c_, int nctx_cols_, int ctx_col0_) { so.init(NLAT, DIN, G_, c_); G = G_; c = c_; nctx_cols = nctx_cols_; ctx_col0 = ctx_col0_; }
    __device__ bool next(int i, pg8::Unit& u) const {
        const int L = i * G + c;
        if (L < 1920) return so.next(i, u);
        const int r = L - 1920; if (r >= 8 * nctx_cols) return false;
        u.pm = 128 + (r & 7); u.pn = ctx_col0 + (r >> 3); return true;
    }
    __device__ __forceinline__ void a_ready(const pg8::Unit&) const {}
    __device__ __forceinline__ void done(const pg8::Unit&) const {}
};

#ifndef PROBE_REP
#define PROBE_REP -1
#endif
#ifndef PROBE_SUB
#define PROBE_SUB 0
#endif
constexpr int LDS_BYTES = 147456;
struct MegaArgs { const float* in[20]; float* out; unsigned char* ws; int ph_lo, ph_hi; };

__global__ void __launch_bounds__(512, 2) mega(MegaArgs a) {
    extern __shared__ __attribute__((aligned(16))) unsigned char lds[];
    cg::grid_group grid = cg::this_grid();
    unsigned char* ws = a.ws;
    bf16_t* WIN = (bf16_t*)(ws + WS_WIN); bf16_t* H = (bf16_t*)(ws + WS_H);
    const int lo = a.ph_lo, hi = a.ph_hi;
#define IN(k) (lo <= (k) && (k) < hi)
#define BOTH(k) (IN(k) && IN((k) + 1))
    for (int rep = 0; rep < (PROBE_REP == 0 ? 2 : 1); ++rep)
    if (IN(0)) { int tid_ = threadIdx.x; asm volatile("" : "+v"(tid_)); pro::p0((char*)lds, a.in, ws, tid_, (int)gridDim.x); if (BOTH(0)) grid.sync(); }
    for (int rep = 0; rep < (PROBE_REP == 1 ? 2 : 1); ++rep)
    if (IN(1)) { int tid_ = threadIdx.x; asm volatile("" : "+v"(tid_)); pro::p1(a.in, ws, tid_, (int)gridDim.x); if (BOTH(1)) grid.sync(); }
#pragma unroll 1
    for (int l = 0; l < NL; ++l) {
        const int ph = 2 + 2 * l;
        for (int rep = 0; rep < (PROBE_REP == ph ? 2 : 1); ++rep)
        if (IN(ph)) {
            pg8::Gemm g{H, WIN + (size_t)l * DIN * DM, MROWS, DIN, DM};
            InSched S; S.init((int)gridDim.x, (int)blockIdx.x, l == 0 ? 15 : 4, l == 0 ? 0 : 2);
            EpiInProj E{(bf16_t*)(ws + WS_QB), (bf16_t*)(ws + WS_KB), (bf16_t*)(ws + WS_VB), (bf16_t*)(ws + WS_GB), (const float2*)(ws + WS_ROPE)};
            pg8::gemm_phase<EpiInProj, InSched, true, true>((PG8_LAS unsigned char*)lds, g, S, E);
            if (BOTH(ph)) grid.sync();
        }
        for (int rep = 0; rep < (PROBE_REP == ph + 1 ? 2 : 1); ++rep)
        if (IN(ph + 1)) {
            float s1 = 0.f, s2 = 0.f;
            for (int d = 0; d < 64; ++d) { s1 += a.in[8][l * 64 + d] * a.in[9][l * 64 + d]; s2 += a.in[10][l * 64 + d] * a.in[11][l * 64 + d]; }
            const float lam_init = 0.8f - 0.6f * expf(-0.3f * (float)l);
            const float lam = expf(s1) - expf(s2) + lam_init;
            att::Params P{(const bf16_t*)(ws + WS_QB), (const bf16_t*)(ws + WS_KB), (const bf16_t*)(ws + WS_VB), (const bf16_t*)(ws + WS_GB), (bf16_t*)(ws + WS_AT), a.in[12] + l * 128, lam, lam_init};
            __syncthreads();
            const int nun = (l == 0) ? 272 : 256;
            const bool last = (l == NL - 1);
            const float* MODl = (const float*)(ws + WS_MOD) + (size_t)l * 9 * 3072; const float* MODn = (const float*)(ws + WS_MOD) + (size_t)(last ? l : l + 1) * 9 * 3072;
            const bf16_t* WOUTl = (const bf16_t*)(ws + WS_WOUT) + (size_t)l * DM * DM;
#pragma unroll 1
            for (int u = blockIdx.x; u < nun; u += gridDim.x) {
                const bool lat = u < 256; const int v = lat ? u : u - 256; const int b = v & 7, qt = v >> 3;
                tail::Unit U; U.hr0 = lat ? b * SEQ + qt * 128 : NLAT + b * CTX + qt * 128; U.t0 = qt * 128; U.len = lat ? SEQ : CTX; U.mrow = lat ? b : 8;
                U.xin = lat ? ((l == 0 ? a.in[0] : (const float*)a.out) + (size_t)U.hr0 * DM) : (a.in[2] + (size_t)(b * CTX + qt * 128) * DM);
                U.xout = lat ? (a.out + (size_t)U.hr0 * DM) : ((float*)(ws + WS_CTX1) + (size_t)(b * CTX + qt * 128) * DM);
                for (int r_ = 0; r_ < ((PROBE_SUB == 1 && l == 0) ? 2 : 1); ++r_)
                att::attn_unit((char*)lds, P, U.hr0, b * KEYS, lat ? KEYS / 64 : CTX / 64);
                int tid_ = threadIdx.x; asm volatile("" : "+v"(tid_)); const int tid = tid_;
                for (int r_ = 0; r_ < ((PROBE_SUB == 2 && l == 0) ? 2 : 1); ++r_) {
                tail::conv_b(P.GB, P.AT, a.in[13] + l * 3 * 256, U, tid);
                tail::conv_c((char*)lds, P.GB, P.AT, a.in[14] + l * 31 * 256, a.in[15] + l * 256, a.in[16] + l * 256, a.in[17] + l * 256, U, tid); }
                asm volatile("s_waitcnt vmcnt(0)" ::: "memory"); __syncthreads();
                for (int r_ = 0; r_ < ((PROBE_SUB == 3 && l == 0) ? 2 : 1); ++r_) {
                asm volatile("s_waitcnt vmcnt(0)" ::: "memory"); __syncthreads();
                tail::outproj((char*)lds, P.AT + (size_t)U.hr0 * DM, WOUTl, U, MODl + (size_t)U.mrow * 3072 + 2048, tid); }
                asm volatile("s_waitcnt vmcnt(0)" ::: "memory"); __syncthreads();
                for (int r_ = 0; r_ < ((PROBE_SUB == 4 && l == 0) ? 2 : 1); ++r_)
                tail::rowpass(U, last && lat, last ? a.in[19] : a.in[6] + (l + 1) * DM, MODn, (bf16_t*)(ws + WS_H), tid);
            }
            if (BOTH(ph + 1)) grid.sync();
        }
    }
#undef IN
#undef BOTH
}

static int launch_mega(MegaArgs& a, int lo, int hi, hipStream_t stream) {
    static int grid = 0;
    if (grid == 0) {
        int dev = 0, cus = 0, per_cu = 0;
        (void)hipGetDevice(&dev); (void)hipDeviceGetAttribute(&cus, hipDeviceAttributeMultiprocessorCount, dev);
        if (hipFuncSetAttribute((const void*)mega, hipFuncAttributeMaxDynamicSharedMemorySize, LDS_BYTES) != hipSuccess) { fprintf(stderr, "hipFuncSetAttribute failed\n"); grid = -1; return -1; }
        (void)hipOccupancyMaxActiveBlocksPerMultiprocessor(&per_cu, (const void*)mega, 512, LDS_BYTES);
        if (per_cu < 1) { fprintf(stderr, "mega: occupancy query says %d blocks/CU\n", per_cu); grid = -1; return -1; }
        grid = cus;
    }
    if (grid < 0) return -1;
    a.ph_lo = lo; a.ph_hi = hi;
    void* args[] = {&a};
    hipError_t e = hipLaunchCooperativeKernel((const void*)mega, dim3(grid), dim3(512), args, LDS_BYTES, stream);
    if (e != hipSuccess) { fprintf(stderr, "cooperative launch failed: %s (grid %d)\n", hipGetErrorString(e), grid); return -1; }
    return 0;
}

extern "C" void kernel_launch(void* const* d_in, const int* in_sizes, int n_in, void* d_out, int out_size, void* d_ws, size_t ws_size, hipStream_t stream) {
    if (n_in != 20 || in_sizes[0] != NLAT * DM || out_size != NLAT * DM || ws_size < WS_END) {
        fprintf(stderr, "kernel_launch: unexpected shapes (n_in %d in0 %d out %d ws %zu)\n", n_in, n_in > 0 ? in_sizes[0] : -1, out_size, ws_size); return; }
    MegaArgs ma{}; for (int i = 0; i < 20; ++i) ma.in[i] = (const float*)d_in[i]; ma.out = (float*)d_out; ma.ws = (unsigned char*)d_ws;
    (void)launch_mega(ma, 0, 6, stream);
}
```

```cpp
#include <hip/hip_runtime.h>
#include <stdint.h>
#include <stdio.h>

typedef unsigned short bf16_t;
typedef short bf16x8 __attribute__((ext_vector_type(8)));
typedef float f32x16 __attribute__((ext_vector_type(16)));
typedef float f32x4 __attribute__((ext_vector_type(4)));

constexpr int NB = 8, SEQ = 4096, DM = 1024, NL = 2, CTX = 256, DIN = 3840;
constexpr int NLAT = NB * SEQ;
constexpr int NCTX = NB * CTX;
constexpr int MROWS = NLAT + NCTX;
constexpr int KEYS = CTX + SEQ;
constexpr int GW = 2304;
constexpr float EPS = 1e-6f;
constexpr float C2 = 0.125f * 1.4426950408889634f;

constexpr size_t MiB = 1u << 20;
constexpr size_t WS_CTL = 0;
constexpr size_t WS_MOD = 1 * MiB;
constexpr size_t WS_ROPE = WS_MOD + 512 * 1024;
constexpr size_t WS_WIN = 2 * MiB;
constexpr size_t WS_WOUT = 18 * MiB;
constexpr size_t WS_H = 22 * MiB;
constexpr size_t WS_QB = 94 * MiB;
constexpr size_t WS_KB = 130 * MiB;
constexpr size_t WS_VB = 164 * MiB;
constexpr size_t WS_GB = 198 * MiB;
constexpr size_t WS_CTX1 = 360 * MiB;
constexpr size_t WS_AT = 368 * MiB;
constexpr size_t WS_END = 440 * MiB;

__device__ __forceinline__ float bf2f(bf16_t v) { return __uint_as_float((unsigned)v << 16); }
__device__ __forceinline__ bf16_t f2bf(float f) { unsigned u = __float_as_uint(f); return (bf16_t)((u + 0x7fffu + ((u >> 16) & 1u)) >> 16); }
__device__ __forceinline__ float silu_f(float x) { return x / (1.f + __expf(-x)); }
__device__ __forceinline__ float sigmoid_f(float x) { return 1.f / (1.f + __expf(-x)); }
__device__ __forceinline__ float wave_sum(float v) {
#pragma unroll
    for (int o = 1; o < 64; o <<= 1) v += __shfl_xor(v, o);
    return v;
}

#include <hip/hip_cooperative_groups.h>
namespace cg = cooperative_groups;
namespace pg8 {
#define PG8_LAS __attribute__((address_space(3)))
typedef unsigned short bf16_t;
typedef short bf16x8 __attribute__((ext_vector_type(8)));
typedef float f32x4 __attribute__((ext_vector_type(4)));
typedef unsigned u32x4 __attribute__((ext_vector_type(4)));
constexpr int BM = 256, BK = 64, HALF = 128, HTB = HALF * BK * 2  , STAGE_BYTES = 8 * HTB, NXCD = 8, WGM = 8;

__host__ __device__ __forceinline__ int lds_byte(int r, int c) { const int st = (r >> 4) * 2 + (c >> 5), rr = r & 15, cc = c & 31, ob = rr * 64 + cc * 2; return st * 1024 + (ob ^ (((ob >> 9) & 1) << 5)); }
__host__ __device__ __forceinline__ void stage_rc(int b, int& R, int& C) { const int st = b / 1024, sb = b % 1024, swz = sb ^ (((sb >> 9) & 1) << 5); R = (st >> 1) * 16 + swz / 64; C = (st & 1) * 32 + (swz % 64) / 2; }
__host__ __device__ __forceinline__ int perm32(int rho) { const int n = rho >> 4, i = rho & 15; return 8 * (i >> 2) + 4 * n + (i & 3); }

struct Unit { int pm, pn; };
struct Gemm { const bf16_t* A; const bf16_t* Bt; int M, N, K; };

struct StaticOrder {
    int nM, nN, nwg, G, c;
    __host__ __device__ void init(int M, int N, int G_, int c_) { nM = M / BM; nN = N / BM; nwg = nM * nN; G = G_; c = c_; }
    __host__ __device__ bool next(int i, Unit& u) const {
        const long L = (long)i * G + c; if (L >= nwg) return false;
        int wgid = (int)L; { const int q = nwg / NXCD, r = nwg % NXCD, xcd = wgid % NXCD, off = wgid / NXCD; wgid = (xcd < r ? xcd * (q + 1) : r * (q + 1) + (xcd - r) * q) + off; }
        const int nig = WGM * nN, gid = wgid / nig, fm = gid * WGM, gsz = (nM - fm) < WGM ? (nM - fm) : WGM;
        u.pm = fm + ((wgid % nig) % gsz); u.pn = (wgid % nig) / gsz; return true;
    }
    __device__ __forceinline__ void a_ready(const Unit&) const {}
    __device__ __forceinline__ void done(const Unit&) const {}
};

__device__ __forceinline__ unsigned cvt_pk_bf16(float lo, float hi) { unsigned r; asm volatile("v_cvt_pk_bf16_f32 %0, %1, %2" : "=v"(r) : "v"(lo), "v"(hi)); return r; }
template <class Epi, class Sched, bool ALIGN_EPI = false, bool SP2 = false>
__device__ __forceinline__ void gemm_phase(PG8_LAS unsigned char* lds, const Gemm g, const Sched& S, const Epi& E) {
    int tid_ = threadIdx.x; asm volatile("" : "+v"(tid_));
    const int tid = tid_, wid = __builtin_amdgcn_readfirstlane(tid >> 6), lane = tid & 63, wr = wid >> 2, wc = wid & 3, fr = lane & 15, fq = lane >> 4;
    const int K = g.K, nt = K / BK;
    unsigned voffA[2], voffB[2];
#pragma unroll
    for (int i = 0; i < 2; ++i) { int R, C; stage_rc(tid * 16 + i * 8192, R, C); const int Rb = Epi::PERM ? ((R & ~31) + perm32(R & 31)) : R;
        voffA[i] = (unsigned)(R * K + C) * 2u; voffB[i] = (unsigned)(Rb * K + C) * 2u; }
    const size_t kstep = (size_t)(BK * 2);
    const size_t hstep = (size_t)HALF * K * 2;
    const size_t tstep = 2 * hstep;
    const unsigned ldsw = (unsigned)wid * 1024u;
    const int aoff = lds_byte(wr * 64 + fr, fq * 8), boff = lds_byte(wc * 32 + fr, fq * 8);
#define PG8_SA(b, h) (((b) * 2 + (h)) * HTB)
#define PG8_SB(b, h) ((4 + (b) * 2 + (h)) * HTB)
#define PG8_STAGE(bufoff, gbase, voff) do { _Pragma("unroll") for (int _i = 0; _i < 2; ++_i) \
        __builtin_amdgcn_global_load_lds((const unsigned*)((const char*)(gbase) + (voff)[_i]), (PG8_LAS unsigned*)(lds + (bufoff) + ldsw + _i * 8192), 16, 0, 0); } while (0)
#define PG8_LDA(dst, b, h) do { _Pragma("unroll") for (int m = 0; m < 4; ++m) _Pragma("unroll") for (int k = 0; k < 2; ++k) dst[m][k] = *(const PG8_LAS bf16x8*)(lds + PG8_SA(b, h) + aoff + m * 2048 + k * 1024); } while (0)
#define PG8_LDB(dst, b, h) do { _Pragma("unroll") for (int n = 0; n < 2; ++n) _Pragma("unroll") for (int k = 0; k < 2; ++k) dst[n][k] = *(const PG8_LAS bf16x8*)(lds + PG8_SB(b, h) + boff + n * 2048 + k * 1024); } while (0)
#define PG8_MMA(ai, bj, At, Bt) do { __builtin_amdgcn_s_setprio(1); _Pragma("unroll") for (int m = 0; m < 4; ++m) _Pragma("unroll") for (int n = 0; n < 2; ++n) _Pragma("unroll") for (int k = 0; k < 2; ++k) \
        acc[ai][bj][m][n] = __builtin_amdgcn_mfma_f32_16x16x32_bf16(Bt[n][k], At[m][k], acc[ai][bj][m][n], 0, 0, 0); __builtin_amdgcn_s_setprio(0); } while (0)
#define PG8_WAIT_V(n) asm volatile("s_waitcnt vmcnt(" #n ")" ::: "memory")
#define PG8_WAIT_L(n) asm volatile("s_waitcnt lgkmcnt(" #n ")" ::: "memory")
#define PG8_BAR __builtin_amdgcn_s_barrier()
#define PG8_SCHED __builtin_amdgcn_sched_barrier(0)
    Unit cur, nxt; int ui = 0;
    if (!S.next(0, cur)) return;
    f32x4 acc[2][2][4][2];
#pragma unroll
    for (int a = 0; a < 2; ++a)
#pragma unroll
        for (int b = 0; b < 2; ++b)
#pragma unroll
            for (int m = 0; m < 4; ++m)
#pragma unroll
                for (int n = 0; n < 2; ++n) acc[a][b][m][n] = (f32x4){0.f, 0.f, 0.f, 0.f};
    bf16x8 At[4][2], B0[2][2], B1[2][2];
    const char* cA = (const char*)g.A + (size_t)cur.pm * tstep; const char* cB = (const char*)g.Bt + (size_t)cur.pn * tstep;
    S.a_ready(cur);
    if constexpr (SP2) {
        PG8_STAGE(PG8_SB(0, 0), cB, voffB); PG8_STAGE(PG8_SB(0, 1), cB + hstep, voffB); PG8_STAGE(PG8_SA(0, 0), cA, voffA); PG8_STAGE(PG8_SA(0, 1), cA + hstep, voffA);
        if (wr == 1) PG8_BAR;
        PG8_WAIT_V(2); PG8_BAR;
        PG8_STAGE(PG8_SB(1, 0), cB + kstep, voffB); PG8_STAGE(PG8_SA(1, 0), cA + kstep, voffA); PG8_STAGE(PG8_SB(1, 1), cB + hstep + kstep, voffB);
        PG8_WAIT_V(6); PG8_BAR;
    } else {
        PG8_STAGE(PG8_SB(0, 0), cB, voffB); PG8_STAGE(PG8_SA(0, 0), cA, voffA); PG8_STAGE(PG8_SB(0, 1), cB + hstep, voffB); PG8_STAGE(PG8_SA(0, 1), cA + hstep, voffA);
        if (wr == 1) PG8_BAR;
        PG8_WAIT_V(4); PG8_BAR;
        PG8_STAGE(PG8_SB(1, 0), cB + kstep, voffB); PG8_STAGE(PG8_SA(1, 0), cA + kstep, voffA); PG8_STAGE(PG8_SB(1, 1), cB + hstep + kstep, voffB);
        PG8_WAIT_V(6); PG8_BAR;
    }
    for (;;) {
        const bool has_next = S.next(ui + 1, nxt);
        const char* nA = has_next ? (const char*)g.A + (size_t)nxt.pm * tstep : cA; const char* nB = has_next ? (const char*)g.Bt + (size_t)nxt.pn * tstep : cB;
        for (int t = 0; t < nt; t += 2) {
            const bool last = (t == nt - 2);
            const char* a1 = cA + (size_t)(t + 1) * kstep;
            const char* a2 = last ? nA : cA + (size_t)(t + 2) * kstep; const char* b2 = last ? nB : cB + (size_t)(t + 2) * kstep;
            const char* a3 = a2 + kstep; const char* b3 = b2 + kstep;
            if (last && has_next) S.a_ready(nxt);
            if constexpr (SP2) {
            PG8_LDB(B0, 0, 0); PG8_LDB(B1, 0, 1); PG8_SCHED; PG8_LDA(At, 0, 0); PG8_STAGE(PG8_SA(1, 1), a1 + hstep, voffA);
            PG8_WAIT_V(8); PG8_WAIT_L(0); PG8_BAR; PG8_MMA(0, 0, At, B0); PG8_MMA(0, 1, At, B1); PG8_BAR; PG8_SCHED;
            PG8_LDA(At, 0, 1); PG8_STAGE(PG8_SB(0, 0), b2, voffB); PG8_STAGE(PG8_SB(0, 1), b2 + hstep, voffB); PG8_STAGE(PG8_SA(0, 0), a2, voffA);
            PG8_WAIT_V(8); PG8_WAIT_L(0); PG8_BAR; PG8_MMA(1, 0, At, B0); PG8_MMA(1, 1, At, B1); PG8_BAR; PG8_SCHED;
            PG8_LDB(B0, 1, 0); PG8_LDB(B1, 1, 1); PG8_SCHED; PG8_LDA(At, 1, 0); PG8_STAGE(PG8_SA(0, 1), a2 + hstep, voffA);
            PG8_WAIT_V(8); PG8_WAIT_L(0); PG8_BAR; PG8_MMA(0, 0, At, B0); PG8_MMA(0, 1, At, B1); PG8_BAR; PG8_SCHED;
            PG8_LDA(At, 1, 1); PG8_STAGE(PG8_SB(1, 0), b3, voffB); PG8_STAGE(PG8_SB(1, 1), b3 + hstep, voffB); PG8_STAGE(PG8_SA(1, 0), a3, voffA);
            PG8_WAIT_V(8); PG8_WAIT_L(0); PG8_BAR; PG8_MMA(1, 0, At, B0); PG8_MMA(1, 1, At, B1); PG8_BAR; PG8_SCHED;
            } else {
            PG8_LDB(B0, 0, 0); PG8_SCHED; PG8_LDA(At, 0, 0); PG8_STAGE(PG8_SA(1, 1), a1 + hstep, voffA);
            PG8_WAIT_L(8); PG8_BAR; PG8_WAIT_L(0); PG8_MMA(0, 0, At, B0); PG8_BAR; PG8_SCHED;
            PG8_LDB(B1, 0, 1); PG8_STAGE(PG8_SB(0, 0), b2, voffB);
            PG8_BAR; PG8_WAIT_L(0); PG8_MMA(0, 1, At, B1); PG8_BAR;
            PG8_LDA(At, 0, 1); PG8_STAGE(PG8_SA(0, 0), a2, voffA);
            PG8_BAR; PG8_WAIT_L(0); PG8_MMA(1, 0, At, B0); PG8_BAR; PG8_SCHED;
            PG8_STAGE(PG8_SB(0, 1), b2 + hstep, voffB);
            PG8_WAIT_V(6); PG8_BAR; PG8_MMA(1, 1, At, B1); PG8_BAR;
            PG8_LDB(B0, 1, 0); PG8_SCHED; PG8_LDA(At, 1, 0); PG8_STAGE(PG8_SA(0, 1), a2 + hstep, voffA);
            PG8_WAIT_L(8); PG8_BAR; PG8_WAIT_L(0); PG8_MMA(0, 0, At, B0); PG8_BAR; PG8_SCHED;
            PG8_LDB(B1, 1, 1); PG8_STAGE(PG8_SB(1, 0), b3, voffB);
            PG8_BAR; PG8_WAIT_L(0); PG8_MMA(0, 1, At, B1); PG8_BAR;
            PG8_LDA(At, 1, 1); PG8_STAGE(PG8_SA(1, 0), a3, voffA);
            PG8_BAR; PG8_WAIT_L(0); PG8_MMA(1, 0, At, B0); PG8_BAR; PG8_SCHED;
            PG8_STAGE(PG8_SB(1, 1), b3 + hstep, voffB);
            PG8_WAIT_V(6); PG8_BAR; PG8_MMA(1, 1, At, B1); PG8_BAR;
            }
        }
        if constexpr (ALIGN_EPI) { if (wr == 0) PG8_BAR; }
        if constexpr (!Epi::AFTER_DRAIN) { E(acc, cur, wr, wc, fr, fq); S.done(cur); }
        if (!has_next) break;
#pragma unroll
        for (int a = 0; a < 2; ++a)
#pragma unroll
            for (int b = 0; b < 2; ++b)
#pragma unroll
                for (int m = 0; m < 4; ++m)
#pragma unroll
                    for (int n = 0; n < 2; ++n) acc[a][b][m][n] = (f32x4){0.f, 0.f, 0.f, 0.f};
        cur = nxt; cA = nA; cB = nB; ++ui;
        if constexpr (ALIGN_EPI) { if (wr == 1) PG8_BAR; }
    }
    PG8_WAIT_V(0);
    if constexpr (!ALIGN_EPI) { if (wr == 0) PG8_BAR; }
    PG8_BAR;
    if constexpr (Epi::AFTER_DRAIN) { E.fused(acc, cur, wr, wc, fr, fq, lds, wid, lane); S.done(cur); }
#undef PG8_SA
#undef PG8_SB
#undef PG8_STAGE
#undef PG8_LDA
#undef PG8_LDB
#undef PG8_MMA
#undef PG8_WAIT_V
#undef PG8_WAIT_L
#undef PG8_BAR
#undef PG8_SCHED
}
}

namespace att {
typedef __attribute__((address_space(3))) const char* lds_cptr;
typedef __attribute__((address_space(3))) char* lds_ptr;
typedef short s16x4 __attribute__((ext_vector_type(4)));
typedef short v4i16_t __attribute__((ext_vector_type(4)));
typedef unsigned u32x4 __attribute__((ext_vector_type(4)));
typedef float f32x2_t __attribute__((ext_vector_type(2))); typedef __bf16 bf16x2_t __attribute__((ext_vector_type(2)));
constexpr int SLOT = 16384, NSLOT = 3;
constexpr int LDS_K = 0, LDS_V = NSLOT * SLOT, LDS_WS = 2 * NSLOT * SLOT, LDS_STG = LDS_WS + 2048, LDS_END = LDS_STG + 4 * 8192;
constexpr float THR = 8.0f;
#define ATT_SBAR() __builtin_amdgcn_sched_barrier(0)
__device__ __forceinline__ int crow(int r, int hi) { return (r & 3) + 8 * (r >> 2) + 4 * hi; }
__device__ __forceinline__ void glds16(const void* gsrc, unsigned lds_dst) { unsigned keep;
    asm volatile("s_mov_b32 %0, m0\n\ts_mov_b32 m0, %2\n\ts_nop 0\n\tglobal_load_lds_dwordx4 %1, off\n\ts_mov_b32 m0, %0" : "=&s"(keep) : "v"(gsrc), "s"(lds_dst) : "memory"); }
__device__ __forceinline__ unsigned cvtpk_s(float lo, float hi) { f32x2_t v = {lo, hi}; bf16x2_t b = __builtin_convertvector(v, bf16x2_t); return __builtin_bit_cast(unsigned, b); }
__device__ __forceinline__ s16x4 vtr(lds_cptr p) { return __builtin_bit_cast(s16x4, __builtin_amdgcn_ds_read_tr16_b64_v4i16((__attribute__((address_space(3))) v4i16_t*)p)); }
#define ATT_MX3(a, b, c) __builtin_fmaxf(__builtin_fmaxf((a), (b)), (c))
__device__ __forceinline__ float rowmax(const f32x16& p0, const f32x16& p1) {
    float a = ATT_MX3(p0[0], p0[1], p1[0]), b = ATT_MX3(p0[2], p0[3], p1[1]); a = ATT_MX3(a, p1[2], p1[3]);
#pragma unroll
    for (int r = 4; r < 16; r += 4) { a = ATT_MX3(a, p0[r], p0[r + 1]); b = ATT_MX3(b, p0[r + 2], p0[r + 3]); a = ATT_MX3(a, p1[r], p1[r + 1]); b = ATT_MX3(b, p1[r + 2], p1[r + 3]); }
    float m = __builtin_fmaxf(a, b); auto rr = __builtin_amdgcn_permlane32_swap(__float_as_uint(m), __float_as_uint(m), false, false);
    return __builtin_fmaxf(__uint_as_float(rr[0]), __uint_as_float(rr[1])); }

struct Params { const bf16_t* QB; const bf16_t* KB; const bf16_t* VB; const bf16_t* GB; bf16_t* AT; const float* gsub; float lam, lam_init; };

__device__ __forceinline__ void attn_unit(char* shm, const Params& P, int hr0, int kr0, int NT) {
    int tid_ = threadIdx.x; asm volatile("" : "+v"(tid_));
    const int tid = tid_, lane = tid & 63, r32 = lane & 31, hi = lane >> 5; const int wid = __builtin_amdgcn_readfirstlane(tid >> 6);
    const int qblk = wid & 3, m = wid >> 2;
    const unsigned lds0 = (unsigned)(uintptr_t)shm;
    const lds_ptr shm3 = (lds_ptr)shm;
    __attribute__((address_space(3))) float* wsf = (__attribute__((address_space(3))) float*)(shm3 + LDS_WS) + wid * 64;
    const bf16_t* ksrc = P.KB + (size_t)(kr0 + lane) * 512 + wid * 8;
    const bf16_t* vsrc = P.VB + (size_t)(kr0 + 16 * (wid & 3) + (lane >> 2)) * 512 + (wid >> 2) * 32 + (lane & 3) * 8;
    const unsigned kdst = lds0 + LDS_K + wid * 1024, vdst = lds0 + LDS_V + (wid >> 2) * 4096 + (wid & 3) * 1024;
#define ATT_DMA_K(h_, t_, slotoff) do { const size_t go_ = (size_t)(t_) * (64 * 512) + (h_) * 128; \
        glds16(ksrc + go_, (unsigned)__builtin_amdgcn_readfirstlane(kdst + (slotoff))); glds16(ksrc + go_ + 64, (unsigned)__builtin_amdgcn_readfirstlane(kdst + (slotoff) + 8192)); } while (0)
#define ATT_DMA_V(h_, t_, slotoff) do { const size_t go_ = (size_t)(t_) * (64 * 512) + (h_) * 128; \
        glds16(vsrc + go_, (unsigned)__builtin_amdgcn_readfirstlane(vdst + (slotoff))); glds16(vsrc + go_ + 64, (unsigned)__builtin_amdgcn_readfirstlane(vdst + (slotoff) + 8192)); } while (0)
#define ATT_WAIT_BAR(N) asm volatile("s_waitcnt vmcnt(" #N ") lgkmcnt(0)\n\ts_barrier" ::: "memory")
#define ATT_PIN(x) asm volatile("" : "+v"(x))
#define ATT_MF(a_, b_, c_) __builtin_amdgcn_mfma_f32_32x32x16_bf16(a_, b_, c_, 0, 0, 0)
#define ATT_EX(v_) __builtin_amdgcn_exp2f(v_)
#define ATT_LDK(p_) (*(const __attribute__((address_space(3))) bf16x8*)(p_))
    const lds_cptr kp0 = (lds_cptr)shm3 + LDS_K + m * 8192 + hi * 1024 + r32 * 16;
    const lds_cptr vp0 = (lds_cptr)shm3 + LDS_V + ((lane >> 4) & 1) * 32 + (lane & 3) * 8 + (4 * hi + ((lane & 15) >> 2)) * 64;
    const int TT = 4 * NT;
    ATT_DMA_K(0, 0, 0); ATT_DMA_V(0, 0, 0); ATT_DMA_K(0, 1, SLOT);
    int T = 0, sl_prev = 2 * SLOT, sl_cur = 0, sl_next = SLOT;
    int hk = 0, tk = 2, hv = 0, tv = 1;
    bf16x8 qr[4]; f32x16 o[4]; float mhat = 0.f, l_reg = 0.f; bool resc = false;
    f32x16 negm; f32x16 pA0, pA1, pB0, pB1; u32x4 pw0, pw1, pw2, pw3; s16x4 vlo[16], vhi[16]; bf16x8 kfa[2][2];
#pragma unroll
    for (int r = 0; r < 16; ++r) negm[r] = 0.f;
#define ATT_ISSUE() do { if (T + 2 < TT) ATT_DMA_K(hk, tk, sl_prev); if (T + 1 < TT) ATT_DMA_V(hv, tv, sl_next); } while (0)
#define ATT_CLOSE() do { if (T + 2 < TT) ATT_WAIT_BAR(4); else if (T + 1 < TT) ATT_WAIT_BAR(2); else ATT_WAIT_BAR(0); \
        ++T; { const int tmp_ = sl_prev; sl_prev = sl_cur; sl_cur = sl_next; sl_next = tmp_; } if (++tk == NT) { tk = 0; ++hk; } if (++tv == NT) { tv = 0; ++hv; } } while (0)
#define ATT_RESC() do { if (resc) { _Pragma("unroll") for (int d_ = 0; d_ < 4; ++d_) _Pragma("unroll") for (int r = 0; r < 16; ++r) o[d_][r] *= wsf[crow(r, hi)]; } } while (0)
#define ATT_P32(P0, P1, k) ((k) < 16 ? P0[(k) & 15] : P1[(k) & 15])
#define ATT_KRD(d0) do { kfa[(d0) & 1][0] = ATT_LDK(kp_ + (d0) * 2048); kfa[(d0) & 1][1] = ATT_LDK(kp_ + (d0) * 2048 + 512); } while (0)
#define ATT_VRD(i) do { vlo[i] = vtr(vp_ + ((i) & 3) * 4096 + ((i) >> 2) * 1024); vhi[i] = vtr(vp_ + ((i) & 3) * 4096 + ((i) >> 2) * 1024 + 512); } while (0)
#define ATT_VFR(i) (bf16x8){vlo[i][0], vlo[i][1], vlo[i][2], vlo[i][3], vhi[i][0], vhi[i][1], vhi[i][2], vhi[i][3]}
#define ATT_PAF(k) __builtin_bit_cast(bf16x8, (k) == 0 ? pw0 : (k) == 1 ? pw1 : (k) == 2 ? pw2 : pw3)
#define ATT_PWSET(w, val) do { if ((w) < 4) pw0[(w) & 3] = (val); else if ((w) < 8) pw1[(w) & 3] = (val); else if ((w) < 12) pw2[(w) & 3] = (val); else pw3[(w) & 3] = (val); } while (0)
#define ATT_GAPA(i, C0, C1, P0, P1) do { ATT_VRD(i); if (((i) & 1) == 0 && (i) < 6) ATT_KRD(((i) >> 1) + 1); ATT_SBAR(); \
        if (((i) & 1) == 0) C0 = ATT_MF(kfa[((i) >> 1) & 1][0], qr[(i) >> 1], ((i) >> 1) == 0 ? negm : C0); else C1 = ATT_MF(kfa[((i) >> 1) & 1][1], qr[(i) >> 1], ((i) >> 1) == 0 ? negm : C1); \
        sacc += ATT_P32(P0, P1, 4 * (i)); sacc += ATT_P32(P0, P1, 4 * (i) + 1); sacc += ATT_P32(P0, P1, 4 * (i) + 2); sacc += ATT_P32(P0, P1, 4 * (i) + 3); ATT_PIN(sacc); \
        ATT_PWSET(2 * (i), cvtpk_s(ATT_P32(P0, P1, 4 * (i)), ATT_P32(P0, P1, 4 * (i) + 1))); ATT_PWSET(2 * (i) + 1, cvtpk_s(ATT_P32(P0, P1, 4 * (i) + 2), ATT_P32(P0, P1, 4 * (i) + 3))); \
        if ((i) < 2) ATT_PIN(pw0); else if ((i) < 4) ATT_PIN(pw1); else if ((i) < 6) ATT_PIN(pw2); else ATT_PIN(pw3); ATT_SBAR(); } while (0)
#define ATT_GAPB(j, C0, C1) do { if ((j) < 8) { ATT_VRD(8 + (j)); ATT_SBAR(); } \
        o[(j) & 3] = ATT_MF(ATT_PAF((j) >> 2), ATT_VFR(j), o[(j) & 3]); \
        if ((j) < 8) { C0[2 * (j)] = ATT_EX(C0[2 * (j)]); C0[2 * (j) + 1] = ATT_EX(C0[2 * (j) + 1]); ATT_PIN(C0); } else { C1[2 * (j) - 16] = ATT_EX(C1[2 * (j) - 16]); C1[2 * (j) - 15] = ATT_EX(C1[2 * (j) - 15]); ATT_PIN(C1); } ATT_SBAR(); } while (0)
#define ATT_STEP(C0, C1, P0, P1) do { ATT_SBAR(); \
        const lds_cptr vp_ = vp0 + sl_prev; const lds_cptr kp_ = kp0 + sl_cur; float sacc = 0.f; \
        ATT_KRD(0); \
        ATT_GAPA(0, C0, C1, P0, P1); ATT_GAPA(1, C0, C1, P0, P1); ATT_GAPA(2, C0, C1, P0, P1); ATT_GAPA(3, C0, C1, P0, P1); \
        ATT_GAPA(4, C0, C1, P0, P1); ATT_GAPA(5, C0, C1, P0, P1); ATT_GAPA(6, C0, C1, P0, P1); ATT_GAPA(7, C0, C1, P0, P1); \
        l_reg += sacc; \
        ATT_ISSUE(); \
        { const float rm = rowmax(C0, C1); resc = false; \
          if (__builtin_expect(__any(rm > THR), 0)) { const float dl = __builtin_fmaxf(rm, 0.f); mhat += dl; \
              _Pragma("unroll") for (int r = 0; r < 16; ++r) { C0[r] -= dl; C1[r] -= dl; } \
              _Pragma("unroll") for (int r = 0; r < 16; ++r) negm[r] = -mhat; ATT_PIN(negm); \
              const float f = __builtin_amdgcn_exp2f(-dl); l_reg *= f; if (hi == 0) wsf[r32] = f; resc = true; } } \
        ATT_SBAR(); \
        ATT_GAPB(0, C0, C1); ATT_GAPB(1, C0, C1); ATT_GAPB(2, C0, C1); ATT_GAPB(3, C0, C1); ATT_GAPB(4, C0, C1); ATT_GAPB(5, C0, C1); ATT_GAPB(6, C0, C1); ATT_GAPB(7, C0, C1); \
        ATT_GAPB(8, C0, C1); ATT_GAPB(9, C0, C1); ATT_GAPB(10, C0, C1); ATT_GAPB(11, C0, C1); ATT_GAPB(12, C0, C1); ATT_GAPB(13, C0, C1); ATT_GAPB(14, C0, C1); ATT_GAPB(15, C0, C1); \
        ATT_CLOSE(); ATT_RESC(); } while (0)

    ATT_WAIT_BAR(0);
#pragma unroll 1
    for (int h = 0; h <= 4; ++h) {
        if (h < 4) {
            ATT_ISSUE();
            const bf16_t* qp = P.QB + (size_t)(hr0 + 32 * qblk + r32) * 512 + h * 128 + m * 64 + hi * 8;
#pragma unroll
            for (int d0 = 0; d0 < 4; ++d0) qr[d0] = *(const bf16x8*)(qp + d0 * 16);
        }
        if (h > 0) {
            const int ho = h - 1;
            { float sacc = 0.f;
#pragma unroll
              for (int r = 0; r < 16; ++r) sacc += pB0[r] + pB1[r];
              l_reg += sacc; }
            pw0 = (u32x4){cvtpk_s(pB0[0], pB0[1]), cvtpk_s(pB0[2], pB0[3]), cvtpk_s(pB0[4], pB0[5]), cvtpk_s(pB0[6], pB0[7])};
            pw1 = (u32x4){cvtpk_s(pB0[8], pB0[9]), cvtpk_s(pB0[10], pB0[11]), cvtpk_s(pB0[12], pB0[13]), cvtpk_s(pB0[14], pB0[15])};
            pw2 = (u32x4){cvtpk_s(pB1[0], pB1[1]), cvtpk_s(pB1[2], pB1[3]), cvtpk_s(pB1[4], pB1[5]), cvtpk_s(pB1[6], pB1[7])};
            pw3 = (u32x4){cvtpk_s(pB1[8], pB1[9]), cvtpk_s(pB1[10], pB1[11]), cvtpk_s(pB1[12], pB1[13]), cvtpk_s(pB1[14], pB1[15])};
            { const lds_cptr vp = vp0 + sl_prev;
#pragma unroll
              for (int ks = 0; ks < 4; ++ks)
#pragma unroll
                  for (int db = 0; db < 4; ++db) {
                      const s16x4 lo = vtr(vp + db * 4096 + ks * 1024), hh = vtr(vp + db * 4096 + ks * 1024 + 512);
                      const bf16x8 vf = (bf16x8){lo[0], lo[1], lo[2], lo[3], hh[0], hh[1], hh[2], hh[3]};
                      o[db] = ATT_MF(ATT_PAF(ks), vf, o[db]); } }
            { auto rr = __builtin_amdgcn_permlane32_swap(__float_as_uint(l_reg), __float_as_uint(l_reg), false, false); l_reg = __uint_as_float(rr[0]) + __uint_as_float(rr[1]); }
            if (hi == 0) wsf[32 + r32] = l_reg;
            asm volatile("s_waitcnt lgkmcnt(0)" ::: "memory");
            float rli[16];
#pragma unroll
            for (int r = 0; r < 16; ++r) rli[r] = __builtin_amdgcn_rcpf(wsf[32 + crow(r, hi)]) * (m == 1 ? P.lam : 1.0f);
#pragma unroll
            for (int d = 0; d < 4; ++d)
#pragma unroll
                for (int r = 0; r < 16; ++r) o[d][r] *= rli[r];
            __attribute__((address_space(3))) unsigned* stg = (__attribute__((address_space(3))) unsigned*)(shm3 + LDS_STG + qblk * 8192) + lane;
            if (m == 1) {
#pragma unroll
                for (int d = 0; d < 4; ++d)
#pragma unroll
                    for (int r2 = 0; r2 < 8; ++r2) stg[(d * 8 + r2) * 64] = cvtpk_s(o[d][2 * r2], o[d][2 * r2 + 1]);
            }
            asm volatile("s_waitcnt lgkmcnt(0)\n\ts_barrier" ::: "memory");
            if (m == 0) {
                float ss[16];
#pragma unroll
                for (int r = 0; r < 16; ++r) ss[r] = 0.f;
#pragma unroll
                for (int d = 0; d < 4; ++d)
#pragma unroll
                    for (int r2 = 0; r2 < 8; ++r2) { const unsigned w = stg[(d * 8 + r2) * 64];
                        o[d][2 * r2] -= __uint_as_float(w << 16); o[d][2 * r2 + 1] -= __uint_as_float(w & 0xffff0000u);
                        ss[2 * r2] += o[d][2 * r2] * o[d][2 * r2]; ss[2 * r2 + 1] += o[d][2 * r2 + 1] * o[d][2 * r2 + 1]; }
#pragma unroll
                for (int r = 0; r < 16; ++r) { float v = ss[r]; v += __shfl_xor(v, 1); v += __shfl_xor(v, 2); v += __shfl_xor(v, 4); v += __shfl_xor(v, 8); v += __shfl_xor(v, 16);
                    ss[r] = (1.0f / sqrtf(v * (1.f / 128.f) + EPS)) * (1.f - P.lam_init); }
                __attribute__((address_space(3))) bf16_t* tl = (__attribute__((address_space(3))) bf16_t*)(shm3 + LDS_STG + qblk * 8192);
                asm volatile("s_waitcnt lgkmcnt(0)" ::: "memory");
#pragma unroll
                for (int d = 0; d < 4; ++d) { const float gs = P.gsub[32 * d + r32];
#pragma unroll
                    for (int r = 0; r < 16; ++r) tl[crow(r, hi) * 128 + 32 * d + r32] = f2bf(o[d][r] * ss[r] * gs); }
                asm volatile("s_waitcnt lgkmcnt(0)" ::: "memory");
                { const int row = lane >> 1, half = lane & 1; const size_t grow = (size_t)(hr0 + 32 * qblk + row);
                  const bf16_t* gp = P.GB + grow * GW + ho * 128 + half * 64; bf16_t* ap = P.AT + grow * DM + ho * 128 + half * 64;
                  const __attribute__((address_space(3))) u32x4* tp = (const __attribute__((address_space(3))) u32x4*)(tl + row * 128 + half * 64);
                  u32x4 gv[8];
#pragma unroll
                  for (int c = 0; c < 8; ++c) gv[c] = *(const u32x4*)(gp + c * 8);
#pragma unroll
                  for (int c = 0; c < 8; ++c) { const u32x4 v = tp[c]; const u32x4 g = gv[c]; u32x4 w;
#pragma unroll
                      for (int e = 0; e < 4; ++e) { const float a0 = __uint_as_float(v[e] << 16) * silu_f(__uint_as_float(g[e] << 16)), a1 = __uint_as_float(v[e] & 0xffff0000u) * silu_f(__uint_as_float(g[e] & 0xffff0000u));
                          w[e] = cvtpk_s(a0, a1); }
                      *(u32x4*)(ap + c * 8) = w; } }
            }
        }
        if (h == 4) break;
#pragma unroll
        for (int d = 0; d < 4; ++d) o[d] = f32x16{};
#pragma unroll
        for (int r = 0; r < 16; ++r) negm[r] = 0.f;
        { const lds_cptr kp = kp0 + sl_cur;
#pragma unroll
          for (int d0 = 0; d0 < 4; ++d0) {
              const bf16x8 k0 = ATT_LDK(kp + d0 * 2048), k1 = ATT_LDK(kp + d0 * 2048 + 512);
              if (d0 == 0) { pA0 = ATT_MF(k0, qr[0], negm); pA1 = ATT_MF(k1, qr[0], negm); } else { pA0 = ATT_MF(k0, qr[d0], pA0); pA1 = ATT_MF(k1, qr[d0], pA1); } } }
        { const float rm = rowmax(pA0, pA1); mhat = rm; l_reg = 0.f; resc = false;
#pragma unroll
          for (int r = 0; r < 16; ++r) { pA0[r] = ATT_EX(pA0[r] - rm); pA1[r] = ATT_EX(pA1[r] - rm); }
#pragma unroll
          for (int r = 0; r < 16; ++r) negm[r] = -mhat;
          ATT_PIN(negm); }
        ATT_CLOSE();
#pragma unroll 1
        for (int t = 1; t + 2 <= NT - 1; t += 2) { ATT_STEP(pB0, pB1, pA0, pA1); ATT_STEP(pA0, pA1, pB0, pB1); }
        ATT_STEP(pB0, pB1, pA0, pA1);
    }
    asm volatile("s_waitcnt vmcnt(0) lgkmcnt(0)\n\ts_barrier" ::: "memory");
#undef ATT_DMA_K
#undef ATT_DMA_V
#undef ATT_WAIT_BAR
#undef ATT_PIN
#undef ATT_MF
#undef ATT_EX
#undef ATT_LDK
#undef ATT_ISSUE
#undef ATT_CLOSE
#undef ATT_RESC
#undef ATT_P32
#undef ATT_KRD
#undef ATT_VRD
#undef ATT_VFR
#undef ATT_PAF
#undef ATT_PWSET
#undef ATT_GAPA
#undef ATT_GAPB
#undef ATT_STEP
}
}

namespace tail {
typedef __attribute__((address_space(3))) char* lds_ptr;
typedef unsigned u32x4 __attribute__((ext_vector_type(4)));
__device__ __forceinline__ void unpack8(const u32x4 v, float (&f)[8]) {
#pragma unroll
    for (int e = 0; e < 4; ++e) { f[2 * e] = __uint_as_float(v[e] << 16); f[2 * e + 1] = __uint_as_float(v[e] & 0xffff0000u); } }
__device__ __forceinline__ u32x4 pack8(const float (&f)[8]) { u32x4 w;
#pragma unroll
    for (int e = 0; e < 4; ++e) w[e] = att::cvtpk_s(f[2 * e], f[2 * e + 1]);
    return w; }

struct Unit { int hr0;
              int t0, len;
              int mrow;
              const float* xin; float* xout; };

__device__ __forceinline__ void conv_b(const bf16_t* __restrict__ GB, bf16_t* __restrict__ AT, const float* wsh, const Unit& U, int tid) {
    const int cv = tid & 31, tg = tid >> 5, c0 = 8 * cv;
    float w[3][8];
#pragma unroll
    for (int j = 0; j < 3; ++j)
#pragma unroll
        for (int e = 0; e < 8; ++e) w[j][e] = wsh[j * 256 + c0 + e];
    float pm[8], pc[8], pn[8];
    auto prod = [&](int tl, float (&p)[8]) {
        const int t = U.t0 + tl;
        if (t >= 0 && t < U.len) { const bf16_t* g = GB + (size_t)(U.hr0 + tl) * GW; float a[8], b[8]; unpack8(*(const u32x4*)(g + 768 + c0), a); unpack8(*(const u32x4*)(g + 1024 + c0), b);
#pragma unroll
            for (int e = 0; e < 8; ++e) p[e] = a[e] * b[e]; }
        else {
#pragma unroll
            for (int e = 0; e < 8; ++e) p[e] = 0.f; } };
    prod(8 * tg - 1, pm); prod(8 * tg, pc);
#pragma unroll
    for (int i = 0; i < 8; ++i) {
        const int tl = 8 * tg + i; prod(tl + 1, pn);
        const bf16_t* g = GB + (size_t)(U.hr0 + tl) * GW; float bb[8], gb[8], y[8]; unpack8(*(const u32x4*)(g + 512 + c0), bb); unpack8(*(const u32x4*)(g + 1280 + c0), gb);
#pragma unroll
        for (int e = 0; e < 8; ++e) { const float acc = w[0][e] * pm[e] + w[1][e] * pc[e] + w[2][e] * pn[e]; y[e] = bb[e] * acc * silu_f(gb[e]); }
        *(u32x4*)(AT + (size_t)(U.hr0 + tl) * DM + 512 + c0) = pack8(y);
#pragma unroll
        for (int e = 0; e < 8; ++e) { pm[e] = pc[e]; pc[e] = pn[e]; }
    }
}

__device__ __forceinline__ void conv_c(char* shm, const bf16_t* __restrict__ GB, bf16_t* __restrict__ AT, const float* wcf, const float* bcf, const float* gln, const float* bln, const Unit& U, int tid) {
    const lds_ptr shm3 = (lds_ptr)shm;
    const int cvh = tid & 15, tg = tid >> 4;
    float v[2][4][8];
#pragma unroll
    for (int hf = 0; hf < 2; ++hf) {
        for (int item = tid; item < 160 * 16; item += 512) {
            const int i = item >> 4, cq = item & 15, t = U.t0 - 15 + i; float u[8];
            if (t >= 0 && t < U.len) { const bf16_t* g = GB + (size_t)(U.hr0 - 15 + i) * GW + 128 * hf + 8 * cq; float a[8], b[8]; unpack8(*(const u32x4*)(g + 1536), a); unpack8(*(const u32x4*)(g + 1792), b);
#pragma unroll
                for (int e = 0; e < 8; ++e) u[e] = a[e] * sigmoid_f(b[e]); }
            else {
#pragma unroll
                for (int e = 0; e < 8; ++e) u[e] = 0.f; }
            __attribute__((address_space(3))) f32x4* d = (__attribute__((address_space(3))) f32x4*)(shm3 + (size_t)(i * 128 + 8 * cq) * 4);
            d[0] = (f32x4){u[0], u[1], u[2], u[3]}; d[1] = (f32x4){u[4], u[5], u[6], u[7]};
        }
        __syncthreads();
        const int c0 = 128 * hf + 8 * cvh;
#pragma unroll
        for (int tt = 0; tt < 4; ++tt)
#pragma unroll
            for (int e = 0; e < 8; ++e) v[hf][tt][e] = bcf[c0 + e];
#pragma unroll 1
        for (int jb = 0; jb < 8; ++jb) {
            float ur[7][8];
#pragma unroll
            for (int q = 0; q < 7; ++q) { const __attribute__((address_space(3))) f32x4* s = (const __attribute__((address_space(3))) f32x4*)(shm3 + (size_t)((4 * tg + 4 * jb + q) * 128 + 8 * cvh) * 4);
                const f32x4 u0 = s[0], u1 = s[1]; ur[q][0] = u0[0]; ur[q][1] = u0[1]; ur[q][2] = u0[2]; ur[q][3] = u0[3]; ur[q][4] = u1[0]; ur[q][5] = u1[1]; ur[q][6] = u1[2]; ur[q][7] = u1[3]; }
#pragma unroll
            for (int jj = 0; jj < 4; ++jj) { const int j = 4 * jb + jj; const int jc = j < 31 ? j : 30; const float wm = j < 31 ? 1.f : 0.f;
                const f32x4 w0 = *(const f32x4*)(wcf + jc * 256 + c0) * wm, w1 = *(const f32x4*)(wcf + jc * 256 + c0 + 4) * wm;
#pragma unroll
                for (int tt = 0; tt < 4; ++tt) {
                    v[hf][tt][0] += w0[0] * ur[tt + jj][0]; v[hf][tt][1] += w0[1] * ur[tt + jj][1]; v[hf][tt][2] += w0[2] * ur[tt + jj][2]; v[hf][tt][3] += w0[3] * ur[tt + jj][3];
                    v[hf][tt][4] += w1[0] * ur[tt + jj][4]; v[hf][tt][5] += w1[1] * ur[tt + jj][5]; v[hf][tt][6] += w1[2] * ur[tt + jj][6]; v[hf][tt][7] += w1[3] * ur[tt + jj][7]; } }
        }
        __syncthreads();
    }
#pragma unroll
    for (int tt = 0; tt < 4; ++tt) {
        float s1 = 0.f;
#pragma unroll
        for (int hf = 0; hf < 2; ++hf)
#pragma unroll
            for (int e = 0; e < 8; ++e) s1 += v[hf][tt][e];
        s1 += __shfl_xor(s1, 1); s1 += __shfl_xor(s1, 2); s1 += __shfl_xor(s1, 4); s1 += __shfl_xor(s1, 8);
        const float mean = s1 * (1.f / 256.f); float s2 = 0.f;
#pragma unroll
        for (int hf = 0; hf < 2; ++hf)
#pragma unroll
            for (int e = 0; e < 8; ++e) { const float d = v[hf][tt][e] - mean; s2 += d * d; }
        s2 += __shfl_xor(s2, 1); s2 += __shfl_xor(s2, 2); s2 += __shfl_xor(s2, 4); s2 += __shfl_xor(s2, 8);
        const float rstd = 1.0f / sqrtf(s2 * (1.f / 256.f) + EPS);
        const int tl = 4 * tg + tt;
#pragma unroll
        for (int hf = 0; hf < 2; ++hf) { const int c0 = 128 * hf + 8 * cvh; float gc[8], y[8]; unpack8(*(const u32x4*)(GB + (size_t)(U.hr0 + tl) * GW + 2048 + c0), gc);
#pragma unroll
            for (int e = 0; e < 8; ++e) { const float z = (v[hf][tt][e] - mean) * rstd * gln[c0 + e] + bln[c0 + e]; y[e] = silu_f(z) * silu_f(gc[e]); }
            *(u32x4*)(AT + (size_t)(U.hr0 + tl) * DM + 768 + c0) = pack8(y); }
    }
}

constexpr int OP_BUF = 49152, OP_A = 0, OP_B = 16384;
__device__ __forceinline__ void outproj(char* shm, const bf16_t* A, const bf16_t* WT, const Unit& U, const float* gt, int tid) {
    const int lane = tid & 63, r32 = lane & 31, hi = lane >> 5; const int wid = __builtin_amdgcn_readfirstlane(tid >> 6), wr = wid >> 2, wc = wid & 3;
    const unsigned lds0 = (unsigned)(uintptr_t)shm; const lds_ptr shm3 = (lds_ptr)shm;
    const int rr = lane >> 3, cs = (lane & 7) ^ rr;
    const bf16_t* asrc0 = A + (size_t)(8 * wid + rr) * DM + 8 * cs;
    const unsigned adst0 = lds0 + OP_A + wid * 1024;
    const bf16_t* bsrc0 = WT + (size_t)(8 * wid + rr) * DM + 8 * cs;
    const unsigned bdst0 = lds0 + OP_B + wid * 1024;
#define OP_STAGE(s_, bo_) do { const int ch_ = (s_) >> 4, kt_ = (s_) & 15; \
        att::glds16(asrc0 + kt_ * 64, (unsigned)__builtin_amdgcn_readfirstlane(adst0 + (bo_))); att::glds16(asrc0 + (size_t)64 * DM + kt_ * 64, (unsigned)__builtin_amdgcn_readfirstlane(adst0 + (bo_) + 8192)); \
        _Pragma("unroll") for (int i_ = 0; i_ < 4; ++i_) att::glds16(bsrc0 + (size_t)(ch_ * 256 + 64 * i_) * DM + kt_ * 64, (unsigned)__builtin_amdgcn_readfirstlane(bdst0 + (bo_) + i_ * 8192)); } while (0)
    f32x16 acc[2][2];
    OP_STAGE(0, 0); OP_STAGE(1, OP_BUF);
    unsigned bo_cur = 0, bo_nn = 2 * OP_BUF;
    int aoff[4], boff[4];
#pragma unroll
    for (int ks = 0; ks < 4; ++ks) { const int sw = ((2 * ks + hi) ^ (r32 & 7)) << 4; aoff[ks] = OP_A + (64 * wr + r32) * 128 + sw; boff[ks] = OP_B + (64 * wc + r32) * 128 + sw; }
    for (int s = 0; s < 64; ++s) {
        if (s + 1 < 64) asm volatile("s_waitcnt vmcnt(6) lgkmcnt(0)\n\ts_barrier" ::: "memory"); else asm volatile("s_waitcnt vmcnt(0) lgkmcnt(0)\n\ts_barrier" ::: "memory");
        if (s + 2 < 64) OP_STAGE(s + 2, bo_nn);
        if ((s & 15) == 0) {
#pragma unroll
            for (int a = 0; a < 2; ++a)
#pragma unroll
                for (int b = 0; b < 2; ++b) acc[a][b] = f32x16{};
        }
        const lds_ptr sb = shm3 + bo_cur;
#pragma unroll
        for (int ks = 0; ks < 4; ++ks) {
            bf16x8 af[2], bfr[2];
#pragma unroll
            for (int mt = 0; mt < 2; ++mt) af[mt] = *(const __attribute__((address_space(3))) bf16x8*)(sb + aoff[ks] + mt * 4096);
#pragma unroll
            for (int nt = 0; nt < 2; ++nt) bfr[nt] = *(const __attribute__((address_space(3))) bf16x8*)(sb + boff[ks] + nt * 4096);
#pragma unroll
            for (int mt = 0; mt < 2; ++mt)
#pragma unroll
                for (int nt = 0; nt < 2; ++nt) acc[mt][nt] = __builtin_amdgcn_mfma_f32_32x32x16_bf16(af[mt], bfr[nt], acc[mt][nt], 0, 0, 0);
        }
        if ((s & 15) == 15) {
            const int ch = s >> 4;
            const unsigned loff = (unsigned)(4 * hi * DM + r32);
#pragma unroll
            for (int nt = 0; nt < 2; ++nt) { const int nu = 256 * ch + 64 * wc + 32 * nt; const float g = gt[nu + r32];
                float xv[2][16];
#pragma unroll
                for (int mt = 0; mt < 2; ++mt)
#pragma unroll
                    for (int r = 0; r < 16; ++r) { const float* pu = U.xin + (size_t)((64 * wr + 32 * mt + (r & 3) + 8 * (r >> 2)) * DM + nu); xv[mt][r] = pu[loff]; }
#pragma unroll
                for (int mt = 0; mt < 2; ++mt)
#pragma unroll
                    for (int r = 0; r < 16; ++r) { float* pu = U.xout + (size_t)((64 * wr + 32 * mt + (r & 3) + 8 * (r >> 2)) * DM + nu); pu[loff] = xv[mt][r] + g * acc[mt][nt][r]; }
                asm volatile("" ::: "memory"); }
        }
        bo_cur = (bo_cur == 2 * OP_BUF) ? 0 : bo_cur + OP_BUF; bo_nn = (bo_nn == 2 * OP_BUF) ? 0 : bo_nn + OP_BUF;
    }
#undef OP_STAGE
}

__device__ __forceinline__ void rowpass(const Unit& U, bool last, const float* g, const float* modn, bf16_t* H, int tid) {
    const int lane = tid & 63; const int wid = __builtin_amdgcn_readfirstlane(tid >> 6);
    const float* sh = modn + (size_t)U.mrow * 3072; const float* sc = sh + 1024;
#pragma unroll 1
    for (int rb = 0; rb < 4; ++rb) {
        f32x4 v[4][4]; float rstd[4];
#pragma unroll
        for (int q = 0; q < 4; ++q) { const f32x4* xr = (const f32x4*)(U.xout + (size_t)(wid * 16 + rb * 4 + q) * DM) + lane;
#pragma unroll
            for (int j = 0; j < 4; ++j) v[q][j] = xr[64 * j]; }
#pragma unroll
        for (int q = 0; q < 4; ++q) { float ss = 0.f;
#pragma unroll
            for (int j = 0; j < 4; ++j) ss += (v[q][j].x * v[q][j].x + v[q][j].y * v[q][j].y) + (v[q][j].z * v[q][j].z + v[q][j].w * v[q][j].w);
            rstd[q] = 1.0f / sqrtf(wave_sum(ss) * (1.f / DM) + EPS); }
#pragma unroll
        for (int q = 0; q < 4; ++q) { const int row = wid * 16 + rb * 4 + q;
            if (last) { f32x4* xr = (f32x4*)(U.xout + (size_t)row * DM) + lane;
#pragma unroll
                for (int j = 0; j < 4; ++j) { const f32x4 gg = *(const f32x4*)(g + 4 * lane + 256 * j); f32x4 o = v[q][j] * rstd[q]; o.x *= gg.x; o.y *= gg.y; o.z *= gg.z; o.w *= gg.w; xr[64 * j] = o; }
            } else { bf16_t* o = H + (size_t)(U.hr0 + row) * DM;
#pragma unroll
                for (int j = 0; j < 4; ++j) { const int k = 4 * lane + 256 * j;
                    const f32x4 gg = *(const f32x4*)(g + k), s1 = *(const f32x4*)(sc + k), s0 = *(const f32x4*)(sh + k);
                    ushort4 w; w.x = f2bf(v[q][j].x * rstd[q] * gg.x * (1.f + s1.x) + s0.x); w.y = f2bf(v[q][j].y * rstd[q] * gg.y * (1.f + s1.y) + s0.y);
                    w.z = f2bf(v[q][j].z * rstd[q] * gg.z * (1.f + s1.z) + s0.z); w.w = f2bf(v[q][j].w * rstd[q] * gg.w * (1.f + s1.w) + s0.w);
                    *(ushort4*)(o + k) = w; } }
        }
    }
}
}

namespace pro {
typedef __attribute__((address_space(3))) float* lds_f;
__device__ __forceinline__ void transpose_item(const float* W, int K, int N, bf16_t* WT, lds_f scr, int item, int lane) {
    const int nblk = N / 32, kb = item / nblk, nb = item % nblk, k0 = 64 * kb, n0 = 32 * nb;
#pragma unroll 8
    for (int i = 0; i < 32; ++i) { const int kk = 2 * i + (lane >> 5); scr[kk * 33 + (lane & 31)] = W[(size_t)(k0 + kk) * N + n0 + (lane & 31)]; }
    asm volatile("s_waitcnt lgkmcnt(0)" ::: "memory");
    const int c = lane & 7;
#pragma unroll
    for (int j = 0; j < 4; ++j) { const int n = (lane >> 3) + 8 * j; const lds_f s = scr + (8 * c) * 33 + n;
        att::u32x4 o; o.x = att::cvtpk_s(s[0 * 33], s[1 * 33]); o.y = att::cvtpk_s(s[2 * 33], s[3 * 33]); o.z = att::cvtpk_s(s[4 * 33], s[5 * 33]); o.w = att::cvtpk_s(s[6 * 33], s[7 * 33]);
        *(att::u32x4*)(WT + (size_t)(n0 + n) * K + k0 + 8 * c) = o; }
    asm volatile("s_waitcnt lgkmcnt(0)" ::: "memory");
}
__device__ __forceinline__ void p0(char* shm, const float* const* in, unsigned char* ws, int tid, int nblocks) {
    const int lane = tid & 63; const int wave = __builtin_amdgcn_readfirstlane(tid >> 6);
    const __attribute__((address_space(3))) char* shm3c = (const __attribute__((address_space(3))) char*)shm; (void)shm3c;
    __attribute__((address_space(3))) char* shm3 = (__attribute__((address_space(3))) char*)shm;
    if (blockIdx.x < 96) {
        lds_f s = (lds_f)shm3;
        lds_f red = (lds_f)(shm3 + 36864);
        const float* c = in[1]; const float* cctx = in[3];
        for (int i = tid; i < 9 * 1024; i += 512) { const int r = i >> 10, k = i & 1023; const float v = r < 8 ? c[r * 1024 + k] : cctx[k]; s[i] = silu_f(v); }
        __syncthreads();
        const int l = blockIdx.x / 48, n = 64 * (blockIdx.x % 48) + (tid & 63), kq = tid >> 6;
        float acc[9];
#pragma unroll
        for (int r = 0; r < 9; ++r) acc[r] = 0.f;
        const float* w = in[4] + (size_t)l * 1024 * 3072 + n;
#pragma unroll 4
        for (int k = kq * 128; k < kq * 128 + 128; ++k) { const float wv = w[(size_t)k * 3072];
#pragma unroll
            for (int r = 0; r < 9; ++r) acc[r] += s[r * 1024 + k] * wv; }
#pragma unroll
        for (int r = 0; r < 9; ++r) red[(kq * 9 + r) * 64 + (tid & 63)] = acc[r];
        __syncthreads();
        if (tid < 64) {
            float* MOD = (float*)(ws + WS_MOD);
#pragma unroll
            for (int r = 0; r < 9; ++r) { float v = 0.f;
#pragma unroll
                for (int q = 0; q < 8; ++q) v += red[(q * 9 + r) * 64 + tid];
                MOD[((size_t)l * 9 + r) * 3072 + n] = v + in[5][l * 3072 + n]; }
        }
        __syncthreads();
    }
    if ((int)blockIdx.x == nblocks - 1) {
        for (int i = tid; i < 1024; i += 512) {
            const int pos = i >> 4, f = i & 15;
            double inv = 1.0; for (int j = 0; j < f; ++j) inv *= 0.5623413251903491;
            const double ang = (double)pos * inv, hp = 1.5707963267948966;
            const double kq = __builtin_floor(ang / hp + 0.5); const double r = ang - kq * hp - kq * 6.123233995736766e-17;
            const double r2 = r * r;
            const double sn = r * (1.0 + r2 * (-1.0 / 6 + r2 * (1.0 / 120 + r2 * (-1.0 / 5040 + r2 * (1.0 / 362880 + r2 * (-1.0 / 39916800 + r2 * (1.0 / 6227020800.0 + r2 * (-1.0 / 1307674368000.0))))))));
            const double cs = 1.0 + r2 * (-0.5 + r2 * (1.0 / 24 + r2 * (-1.0 / 720 + r2 * (1.0 / 40320 + r2 * (-1.0 / 3628800 + r2 * (1.0 / 479001600.0 + r2 * (-1.0 / 87178291200.0 + r2 * (1.0 / 20922789888000.0))))))));
            const int q = ((int)kq) & 3; double co, si;
            if (q == 0) { co = cs; si = sn; } else if (q == 1) { co = -sn; si = cs; } else if (q == 2) { co = -cs; si = -sn; } else { co = sn; si = -cs; }
            ((float2*)(ws + WS_ROPE))[i] = make_float2((float)co, (float)si);
        }
    }
    lds_f scr = (lds_f)(shm3 + 65536 + wave * 8448);
    constexpr int I_IN = (DM / 64) * (DIN / 32), I_OUT = (DM / 64) * (DM / 32), I_L = I_IN + I_OUT;
    const int gw = (int)blockIdx.x * 8 + wave, NGW = nblocks * 8;
    for (int it = gw; it < NL * I_L; it += NGW) {
        const int l = it / I_L, r = it % I_L;
        if (r < I_IN) transpose_item(in[7] + (size_t)l * DM * DIN, DM, DIN, (bf16_t*)(ws + WS_WIN) + (size_t)l * DIN * DM, scr, r, lane);
        else transpose_item(in[18] + (size_t)l * DM * DM, DM, DM, (bf16_t*)(ws + WS_WOUT) + (size_t)l * DM * DM, scr, r - I_IN, lane);
    }
}
__device__ __forceinline__ void p1(const float* const* in, unsigned char* ws, int tid, int nblocks) {
    const int lane = tid & 63; const int wave = __builtin_amdgcn_readfirstlane(tid >> 6);
    const float* MOD0 = (const float*)(ws + WS_MOD); const float* g = in[6]; bf16_t* H = (bf16_t*)(ws + WS_H);
    for (int hr = (int)blockIdx.x * 8 + wave; hr < MROWS; hr += nblocks * 8) {
        const bool lat = hr < NLAT; const float* src = lat ? in[0] + (size_t)hr * DM : in[2] + (size_t)(hr - NLAT) * DM; const int mrow = lat ? (hr >> 12) : 8;
        const f32x4* xr = (const f32x4*)src + lane;
        f32x4 v[4]; float ss = 0.f;
#pragma unroll
        for (int j = 0; j < 4; ++j) { v[j] = xr[64 * j]; ss += (v[j].x * v[j].x + v[j].y * v[j].y) + (v[j].z * v[j].z + v[j].w * v[j].w); }
        const float rstd = 1.0f / sqrtf(wave_sum(ss) * (1.f / DM) + EPS);
        const float* sh = MOD0 + (size_t)mrow * 3072; const float* sc = sh + 1024; bf16_t* o = H + (size_t)hr * DM;
#pragma unroll
        for (int j = 0; j < 4; ++j) { const int k = 4 * lane + 256 * j;
            const f32x4 gg = *(const f32x4*)(g + k), s1 = *(const f32x4*)(sc + k), s0 = *(const f32x4*)(sh + k);
            ushort4 w; w.x = f2bf(v[j].x * rstd * gg.x * (1.f + s1.x) + s0.x); w.y = f2bf(v[j].y * rstd * gg.y * (1.f + s1.y) + s0.y);
            w.z = f2bf(v[j].z * rstd * gg.z * (1.f + s1.z) + s0.z); w.w = f2bf(v[j].w * rstd * gg.w * (1.f + s1.w) + s0.w);
            *(ushort4*)(o + k) = w; }
    }
}
}

struct EpiInProj {
    static constexpr bool PERM = true, AFTER_DRAIN = false;
    bf16_t *QB, *KB, *VB, *GB; const float2* rope;
    __device__ __forceinline__ void operator()(const pg8::f32x4 (&acc)[2][2][4][2], const pg8::Unit& u, int wr, int wc, int fr, int fq) const {
        const bool lat = u.pm < 128; const int b = lat ? (u.pm >> 4) : (u.pm - 128); const int t0 = lat ? (u.pm & 15) * 256 : 0;
        const int hr0 = u.pm * 256, kr0 = b * KEYS + (lat ? CTX : 0) + t0, pn = u.pn;
#pragma unroll
        for (int ai = 0; ai < 2; ++ai)
#pragma unroll
            for (int m = 0; m < 4; ++m) {
                const int rl = 128 * ai + 64 * wr + 16 * m + fr, t = t0 + rl;
#pragma unroll
                for (int bj = 0; bj < 2; ++bj) {
                    const int nl = 128 * bj + 32 * wc + 8 * fq;
                    pg8::f32x4 v0 = acc[ai][bj][m][0], v1 = acc[ai][bj][m][1];
                    bf16_t* dst;
                    if (pn < 4) {
                        if (lat) {
                            const int i0 = (nl & 63) >> 1; const int pos = (i0 < 16) ? (t >> 6) : (t & 63);
                            const pg8::f32x4* rp = (const pg8::f32x4*)(rope + pos * 16 + (i0 & 15)); const pg8::f32x4 c0 = rp[0], c1 = rp[1];
                            pg8::f32x4 o0, o1;
                            o0[0] = v0[0] * c0[0] - v0[1] * c0[1]; o0[1] = v0[0] * c0[1] + v0[1] * c0[0]; o0[2] = v0[2] * c0[2] - v0[3] * c0[3]; o0[3] = v0[2] * c0[3] + v0[3] * c0[2];
                            o1[0] = v1[0] * c1[0] - v1[1] * c1[1]; o1[1] = v1[0] * c1[1] + v1[1] * c1[0]; o1[2] = v1[2] * c1[2] - v1[3] * c1[3]; o1[3] = v1[2] * c1[3] + v1[3] * c1[2];
                            v0 = o0; v1 = o1;
                        }
                        if (pn < 2) { v0 = v0 * C2; v1 = v1 * C2; dst = QB + (size_t)(hr0 + rl) * 512 + pn * 256 + nl; }
                        else dst = KB + (size_t)(kr0 + rl) * 512 + (pn - 2) * 256 + nl;
                    } else if (pn < 6) dst = VB + (size_t)(kr0 + rl) * 512 + (pn - 4) * 256 + nl;
                    else dst = GB + (size_t)(hr0 + rl) * GW + (pn - 6) * 256 + nl;
                    pg8::u32x4 w; w.x = pg8::cvt_pk_bf16(v0[0], v0[1]); w.y = pg8::cvt_pk_bf16(v0[2], v0[3]); w.z = pg8::cvt_pk_bf16(v1[0], v1[1]); w.w = pg8::cvt_pk_bf16(v1[2], v1[3]);
                    *(pg8::u32x4*)dst = w;
                }
            }
    }
};
struct InSched {
    pg8::StaticOrder so; int G, c, nctx_cols, ctx_col0;
    __device__ void init(int G_, int c_, int nctx_cols_, int ctx_col0_) { so.init(NLAT, DIN, G_, c_); G = G_; c = c_; nctx_cols = nctx_cols_; ctx_col0 = ctx_col0_; }
    __device__ bool next(int i, pg8::Unit& u) const {
        const int L = i * G + c;
        if (L < 1920) return so.next(i, u);
        const int r = L - 1920; if (r >= 8 * nctx_cols) return false;
        u.pm = 128 + (r & 7); u.pn = ctx_col0 + (r >> 3); return true;
    }
    __device__ __forceinline__ void a_ready(const pg8::Unit&) const {}
    __device__ __forceinline__ void done(const pg8::Unit&) const {}
};

#ifndef PROBE_REP
#define PROBE_REP -1
#endif
#ifndef PROBE_SUB
#define PROBE_SUB 0
#endif
constexpr int LDS_BYTES = 147456;
struct MegaArgs { const float* in[20]; float* out; unsigned char* ws; int ph_lo, ph_hi; };

__global__ void __launch_bounds__(512, 2) mega(MegaArgs a) {
    extern __shared__ __attribute__((aligned(16))) unsigned char lds[];
    cg::grid_group grid = cg::this_grid();
    unsigned char* ws = a.ws;
    bf16_t* WIN = (bf16_t*)(ws + WS_WIN); bf16_t* H = (bf16_t*)(ws + WS_H);
    const int lo = a.ph_lo, hi = a.ph_hi;
#define IN(k) (lo <= (k) && (k) < hi)
#define BOTH(k) (IN(k) && IN((k) + 1))
    for (int rep = 0; rep < (PROBE_REP == 0 ? 2 : 1); ++rep)
    if (IN(0)) { int tid_ = threadIdx.x; asm volatile("" : "+v"(tid_)); pro::p0((char*)lds, a.in, ws, tid_, (int)gridDim.x); if (BOTH(0)) grid.sync(); }
    for (int rep = 0; rep < (PROBE_REP == 1 ? 2 : 1); ++rep)
    if (IN(1)) { int tid_ = threadIdx.x; asm volatile("" : "+v"(tid_)); pro::p1(a.in, ws, tid_, (int)gridDim.x); if (BOTH(1)) grid.sync(); }
#pragma unroll 1
    for (int l = 0; l < NL; ++l) {
        const int ph = 2 + 2 * l;
        for (int rep = 0; rep < (PROBE_REP == ph ? 2 : 1); ++rep)
        if (IN(ph)) {
            pg8::Gemm g{H, WIN + (size_t)l * DIN * DM, MROWS, DIN, DM};
            InSched S; S.init((int)gridDim.x, (int)blockIdx.x, l == 0 ? 15 : 4, l == 0 ? 0 : 2);
            EpiInProj E{(bf16_t*)(ws + WS_QB), (bf16_t*)(ws + WS_KB), (bf16_t*)(ws + WS_VB), (bf16_t*)(ws + WS_GB), (const float2*)(ws + WS_ROPE)};
            pg8::gemm_phase<EpiInProj, InSched, true, true>((PG8_LAS unsigned char*)lds, g, S, E);
            if (BOTH(ph)) grid.sync();
        }
        for (int rep = 0; rep < (PROBE_REP == ph + 1 ? 2 : 1); ++rep)
        if (IN(ph + 1)) {
            float s1 = 0.f, s2 = 0.f;
            for (int d = 0; d < 64; ++d) { s1 += a.in[8][l * 64 + d] * a.in[9][l * 64 + d]; s2 += a.in[10][l * 64 + d] * a.in[11][l * 64 + d]; }
            const float lam_init = 0.8f - 0.6f * expf(-0.3f * (float)l);
            const float lam = expf(s1) - expf(s2) + lam_init;
            att::Params P{(const bf16_t*)(ws + WS_QB), (const bf16_t*)(ws + WS_KB), (const bf16_t*)(ws + WS_VB), (const bf16_t*)(ws + WS_GB), (bf16_t*)(ws + WS_AT), a.in[12] + l * 128, lam, lam_init};
            __syncthreads();
            const int nun = (l == 0) ? 272 : 256;
            const bool last = (l == NL - 1);
            const float* MODl = (const float*)(ws + WS_MOD) + (size_t)l * 9 * 3072; const float* MODn = (const float*)(ws + WS_MOD) + (size_t)(last ? l : l + 1) * 9 * 3072;
            const bf16_t* WOUTl = (const bf16_t*)(ws + WS_WOUT) + (size_t)l * DM * DM;
#pragma unroll 1
            for (int u = blockIdx.x; u < nun; u += gridDim.x) {
                const bool lat = u < 256; const int v = lat ? u : u - 256; const int b = v & 7, qt = v >> 3;
                tail::Unit U; U.hr0 = lat ? b * SEQ + qt * 128 : NLAT + b * CTX + qt * 128; U.t0 = qt * 128; U.len = lat ? SEQ : CTX; U.mrow = lat ? b : 8;
                U.xin = lat ? ((l == 0 ? a.in[0] : (const float*)a.out) + (size_t)U.hr0 * DM) : (a.in[2] + (size_t)(b * CTX + qt * 128) * DM);
                U.xout = lat ? (a.out + (size_t)U.hr0 * DM) : ((float*)(ws + WS_CTX1) + (size_t)(b * CTX + qt * 128) * DM);
                for (int r_ = 0; r_ < ((PROBE_SUB == 1 && l == 0) ? 2 : 1); ++r_)
                att::attn_unit((char*)lds, P, U.hr0, b * KEYS, lat ? KEYS / 64 : CTX / 64);
                int tid_ = threadIdx.x; asm volatile("" : "+v"(tid_)); const int tid = tid_;
                for (int r_ = 0; r_ < ((PROBE_SUB == 2 && l == 0) ? 2 : 1); ++r_) {
                tail::conv_b(P.GB, P.AT, a.in[13] + l * 3 * 256, U, tid);
                tail::conv_c((char*)lds, P.GB, P.AT, a.in[14] + l * 31 * 256, a.in[15] + l * 256, a.in[16] + l * 256, a.in[17] + l * 256, U, tid); }
                asm volatile("s_waitcnt vmcnt(0)" ::: "memory"); __syncthreads();
                for (int r_ = 0; r_ < ((PROBE_SUB == 3 && l == 0) ? 2 : 1); ++r_) {
                asm volatile("s_waitcnt vmcnt(0)" ::: "memory"); __syncthreads();
                tail::outproj((char*)lds, P.AT + (size_t)U.hr0 * DM, WOUTl, U, MODl + (size_t)U.mrow * 3072 + 2048, tid); }
                asm volatile("s_waitcnt vmcnt(0)" ::: "memory"); __syncthreads();
                for (int r_ = 0; r_ < ((PROBE_SUB == 4 && l == 0) ? 2 : 1); ++r_)
                tail::rowpass(U, last && lat, last ? a.in[19] : a.in[6] + (l + 1) * DM, MODn, (bf16_t*)(ws + WS_H), tid);
            }
            if (BOTH(ph + 1)) grid.sync();
        }
    }
#undef IN
#undef BOTH
}

static int launch_mega(MegaArgs& a, int lo, int hi, hipStream_t stream) {
    static int grid = 0;
    if (grid == 0) {
        int dev = 0, cus = 0, per_cu = 0;
        (void)hipGetDevice(&dev); (void)hipDeviceGetAttribute(&cus, hipDeviceAttributeMultiprocessorCount, dev);
        if (hipFuncSetAttribute((const void*)mega, hipFuncAttributeMaxDynamicSharedMemorySize, LDS_BYTES) != hipSuccess) { fprintf(stderr, "hipFuncSetAttribute failed\n"); grid = -1; return -1; }
        (void)hipOccupancyMaxActiveBlocksPerMultiprocessor(&per_cu, (const void*)mega, 512, LDS_BYTES);
        if (per_cu < 1) { fprintf(stderr, "mega: occupancy query says %d blocks/CU\n", per_cu); grid = -1; return -1; }
        grid = cus;
    }
    if (grid < 0) return -1;
    a.ph_lo = lo; a.ph_hi = hi;
    void* args[] = {&a};
    hipError_t e = hipLaunchCooperativeKernel((const void*)mega, dim3(grid), dim3(512), args, LDS_BYTES, stream);
    if (e != hipSuccess) { fprintf(stderr, "cooperative launch failed: %s (grid %d)\n", hipGetErrorString(e), grid); return -1; }
    return 0;
}

extern "C" void kernel_launch(void* const* d_in, const int* in_sizes, int n_in, void* d_out, int out_size, void* d_ws, size_t ws_size, hipStream_t stream) {
    if (n_in != 20 || in_sizes[0] != NLAT * DM || out_size != NLAT * DM || ws_size < WS_END) {
        fprintf(stderr, "kernel_launch: unexpected shapes (n_in %d in0 %d out %d ws %zu)\n", n_in, n_in > 0 ? in_sizes[0] : -1, out_size, ws_size); return; }
    MegaArgs ma{}; for (int i = 0; i < 20; ++i) ma.in[i] = (const float*)d_in[i]; ma.out = (float*)d_out; ma.ws = (unsigned char*)d_ws;
    (void)launch_mega(ma, 0, 6, stream);
}
```
